# Optimizing an MI355X kernel written in HIP

```python
import jax, jax.numpy as jnp
from jax import lax
import numpy as np

D_MODEL = 4096
BATCH = 2
SEQ = 4096
DEPTH = 1

N_BRANCHES = 2
POOL_WIDTH = D_MODEL // 2
CONV_WIDTH = D_MODEL // 2
POOL_WINDOWS = (2, 4, 8, 16)
N_POOL_GROUPS = len(POOL_WINDOWS)
POOL_GROUP_DIM = POOL_WIDTH // N_POOL_GROUPS
CONV_K = 3
NORM_EPS = 1e-6
SPLIT_SIZES = (POOL_WIDTH, POOL_WIDTH, CONV_WIDTH, CONV_WIDTH, CONV_WIDTH, CONV_WIDTH,
               N_BRANCHES * D_MODEL)
PROJ_WIDTH = sum(SPLIT_SIZES)
SPLIT_POINTS = tuple(int(v) for v in np.cumsum(SPLIT_SIZES)[:-1])

kernel_name = "hybrid_pool_shortconv_gated_merge"


def rmsnorm(x, w):
    xf = x.astype(jnp.float32)
    y = xf * lax.rsqrt(jnp.mean(xf * xf, axis=-1, keepdims=True) + NORM_EPS)
    return (y * w.astype(jnp.float32)).astype(x.dtype)


def causal_multiscale_pool(u, pool_w, pool_scale):
    b, s, _ = u.shape
    ug = u.reshape(b, s, N_POOL_GROUPS, POOL_GROUP_DIM).astype(jnp.float32)
    cs = lax.cumsum(ug, axis=1)
    cs_pad = jnp.concatenate([jnp.zeros((b, 1, N_POOL_GROUPS, POOL_GROUP_DIM), jnp.float32), cs], axis=1)
    t1 = jnp.arange(1, s + 1, dtype=jnp.float32)
    pooled = []
    for g, w in enumerate(POOL_WINDOWS):
        upper = cs_pad[:, 1:, g]
        lower = jnp.concatenate([jnp.zeros((b, w - 1, POOL_GROUP_DIM), jnp.float32),
                                 cs_pad[:, : s + 1 - w, g]], axis=1)
        count = jnp.minimum(t1, jnp.float32(w))[None, :, None]
        pooled.append((upper - lower) / count - ug[:, :, g])
    pooled = jnp.stack(pooled, axis=2).astype(u.dtype)
    mixed = jnp.einsum('bsgc,gcd->bsgd', pooled, pool_w)
    return mixed.reshape(b, s, POOL_WIDTH) * pool_scale


def causal_gated_shortconv(u, b_gate, c_gate, conv_w, conv_b):
    s = u.shape[1]
    v = c_gate * u
    vpad = jnp.pad(v, ((0, 0), (CONV_K - 1, 0), (0, 0)))
    y = conv_b + sum(conv_w[k] * vpad[:, k:k + s] for k in range(CONV_K))
    return b_gate * y


def setup_inputs(seed: int = 0) -> dict:
    key = jax.random.key(seed)
    ks = jax.random.split(key, 11)
    d = D_MODEL
    x = jax.random.normal(ks[0], (BATCH, SEQ, d), jnp.float32)
    norm_w = 1.0 + 0.02 * jax.random.normal(ks[1], (DEPTH, d), jnp.float32)
    w_in = jax.random.normal(ks[2], (DEPTH, d, PROJ_WIDTH), jnp.float32) * d ** -0.5
    pool_w = jax.random.normal(ks[3], (DEPTH, N_POOL_GROUPS, POOL_GROUP_DIM, POOL_GROUP_DIM), jnp.float32) * POOL_GROUP_DIM ** -0.5
    pool_scale = 1.0 + 0.1 * jax.random.normal(ks[4], (DEPTH, POOL_WIDTH), jnp.float32)
    conv_w = jax.random.normal(ks[5], (DEPTH, CONV_K, CONV_WIDTH), jnp.float32) * CONV_K ** -0.5
    conv_b = 0.02 * jax.random.normal(ks[6], (DEPTH, CONV_WIDTH), jnp.float32)
    gate_b = 0.02 * jax.random.normal(ks[7], (DEPTH, N_BRANCHES, d), jnp.float32)
    w_branch = jax.random.normal(ks[8], (DEPTH, N_BRANCHES, POOL_WIDTH, d), jnp.float32) * POOL_WIDTH ** -0.5
    w_out = jax.random.normal(ks[9], (DEPTH, d, d), jnp.float32) * d ** -0.5
    final_norm_w = 1.0 + 0.02 * jax.random.normal(ks[10], (d,), jnp.float32)
    return {"x": x, "norm_w": norm_w, "w_in": w_in, "pool_w": pool_w,
            "pool_scale": pool_scale, "conv_w": conv_w, "conv_b": conv_b,
            "gate_b": gate_b, "w_branch": w_branch, "w_out": w_out,
            "final_norm_w": final_norm_w}


def reference(x, norm_w, w_in, pool_w, pool_scale, conv_w, conv_b, gate_b, w_branch, w_out, final_norm_w):
    b, s, d = x.shape
    for l in range(DEPTH):
        h = rmsnorm(x, norm_w[l])
        proj = jnp.einsum('bsd,de->bse', h, w_in[l])
        u_p, z_p, u_c, b_c, c_c, z_c, g_logit = jnp.split(proj, SPLIT_POINTS, axis=-1)
        y_pool = causal_multiscale_pool(u_p, pool_w[l], pool_scale[l]) * jax.nn.silu(z_p)
        y_conv = causal_gated_shortconv(u_c, b_c, c_c, conv_w[l], conv_b[l]) * jax.nn.silu(z_c)
        ys = jnp.stack([y_pool, y_conv], axis=2)
        br = jnp.einsum('bsnc,ncd->bsnd', ys, w_branch[l])
        gates = jax.nn.sigmoid(g_logit.reshape(b, s, N_BRANCHES, d) + gate_b[l])
        merged = jnp.sum(gates * br, axis=2)
        x = x + jnp.einsum('bsd,de->bse', merged, w_out[l])
    return rmsnorm(x, final_norm_w)
```

```cpp
#include <hip/hip_runtime.h>
#include <cstdio>
#include <cstdint>

#ifndef MK_N_LAUNCHES
#define MK_N_LAUNCHES 1
#endif

#define LAS __attribute__((address_space(3)))
#define GAS __attribute__((address_space(1)))
typedef unsigned short bf16_t;
typedef short bf16x8 __attribute__((ext_vector_type(8)));
typedef float f32x4 __attribute__((ext_vector_type(4)));
typedef unsigned u32x4 __attribute__((ext_vector_type(4)));
typedef unsigned u32x2 __attribute__((ext_vector_type(2)));

constexpr int DM = 4096, BATCH = 2, SEQ = 4096, MROWS = BATCH * SEQ;
constexpr int PWID = 2048, CWID = 2048, PGD = 512;
constexpr int PROJW = 20480;
constexpr int C_UP = 0, C_ZP = 2048, C_UC = 4096, C_BG = 6144, C_CG = 8192, C_ZC = 10240, C_GL = 12288;
constexpr float NORM_EPS = 1e-6f;

__device__ __forceinline__ unsigned cvt_pk_bf16(float lo, float hi) { unsigned r; asm volatile("v_cvt_pk_bf16_f32 %0, %1, %2" : "=v"(r) : "v"(lo), "v"(hi)); return r; }
__device__ __forceinline__ float bf_lo(unsigned w) { return __builtin_bit_cast(float, w << 16); }
__device__ __forceinline__ float bf_hi(unsigned w) { return __builtin_bit_cast(float, w & 0xffff0000u); }
__device__ __forceinline__ float fast_exp_neg(float x) { return __builtin_amdgcn_exp2f(x * -1.4426950408889634f); }
__device__ __forceinline__ float silu_f(float z) { return z * __builtin_amdgcn_rcpf(1.0f + fast_exp_neg(z)); }

namespace pg8 {
constexpr int BM = 256, BK = 64, HALF = 128, HTB = HALF * BK * 2, STAGE_BYTES = 8 * HTB, NXCD = 8, WGM = 8;
__host__ __device__ __forceinline__ int lds_byte(int r, int c) { const int st = (r >> 4) * 2 + (c >> 5), rr = r & 15, cc = c & 31, ob = rr * 64 + cc * 2; return st * 1024 + (ob ^ (((ob >> 9) & 1) << 5)); }
__host__ __device__ __forceinline__ void stage_rc(int b, int& R, int& C) { const int st = b / 1024, sb = b % 1024, swz = sb ^ (((sb >> 9) & 1) << 5); R = (st >> 1) * 16 + swz / 64; C = (st & 1) * 32 + (swz % 64) / 2; }
__host__ __device__ __forceinline__ int perm32(int rho) { const int n = rho >> 4, i = rho & 15; return 8 * (i >> 2) + 4 * n + (i & 3); }

struct Unit { int pm, pn; };
struct Gemm { const bf16_t* A; const bf16_t* Bt; int lda, ldb, K, a_sh, a_stride; };

struct StaticOrder {
    int nM, nN, nwg, G, c;
    __host__ __device__ void init(int M, int N, int G_, int c_) { nM = M / BM; nN = N / BM; nwg = nM * nN; G = G_; c = c_; }
    __host__ __device__ bool next(int i, Unit& u) const {
        const long L = (long)i * G + c; if (L >= nwg) return false;
        int wgid = (int)L; { const int q = nwg / NXCD, r = nwg % NXCD, xcd = wgid % NXCD, off = wgid / NXCD; wgid = (xcd < r ? xcd * (q + 1) : r * (q + 1) + (xcd - r) * q) + off; }
        const int nig = WGM * nN, gid = wgid / nig, fm = gid * WGM, gsz = (nM - fm) < WGM ? (nM - fm) : WGM;
        u.pm = fm + ((wgid % nig) % gsz); u.pn = (wgid % nig) / gsz; return true;
    }
};


struct EpiStoreBf16 {
    static constexpr bool PERM = true, MID = false;
    bf16_t* O; int ldc;
    __device__ __forceinline__ void mid(f32x4 (&)[2][2][4][2], const Unit&, int, int, int, int) const {}
    __device__ __forceinline__ void operator()(const f32x4 (&acc)[2][2][4][2], const Unit& u, int wr, int wc, int fr, int fq) const {
        const int row0 = u.pm * BM + wr * 64 + fr, col0 = u.pn * BM + wc * 32 + 8 * fq;
#pragma unroll
        for (int ai = 0; ai < 2; ++ai)
#pragma unroll
            for (int m = 0; m < 4; ++m) { bf16_t* rowp = O + (size_t)(row0 + ai * HALF + m * 16) * ldc + col0;
#pragma unroll
                for (int bj = 0; bj < 2; ++bj) { const f32x4 v0 = acc[ai][bj][m][0], v1 = acc[ai][bj][m][1];
                    u32x4 w; w.x = cvt_pk_bf16(v0[0], v0[1]); w.y = cvt_pk_bf16(v0[2], v0[3]); w.z = cvt_pk_bf16(v1[0], v1[1]); w.w = cvt_pk_bf16(v1[2], v1[3]);
                    *(u32x4*)(rowp + bj * HALF) = w; } }
    }
};
struct EpiPool {
    static constexpr bool PERM = true, MID = false;
    const bf16_t* proj; const float* pscale; bf16_t* O;
    __device__ __forceinline__ void mid(f32x4 (&)[2][2][4][2], const Unit&, int, int, int, int) const {}
    __device__ __forceinline__ void operator()(const f32x4 (&acc)[2][2][4][2], const Unit& u, int wr, int wc, int fr, int fq) const {
        const int row0 = u.pm * BM + wr * 64 + fr, col0 = u.pn * BM + wc * 32 + 8 * fq;
#pragma unroll
        for (int bj = 0; bj < 2; ++bj) {
            const f32x4 s0 = *(const f32x4*)(pscale + col0 + bj * HALF), s1 = *(const f32x4*)(pscale + col0 + bj * HALF + 4);
#pragma unroll
            for (int ai = 0; ai < 2; ++ai)
#pragma unroll
                for (int m = 0; m < 4; ++m) { const size_t row = (size_t)(row0 + ai * HALF + m * 16);
                    const u32x4 z = *(const u32x4*)(proj + row * PROJW + C_ZP + col0 + bj * HALF);
                    const f32x4 v0 = acc[ai][bj][m][0], v1 = acc[ai][bj][m][1];
                    u32x4 w;
                    w.x = cvt_pk_bf16(v0[0] * s0[0] * silu_f(bf_lo(z.x)), v0[1] * s0[1] * silu_f(bf_hi(z.x)));
                    w.y = cvt_pk_bf16(v0[2] * s0[2] * silu_f(bf_lo(z.y)), v0[3] * s0[3] * silu_f(bf_hi(z.y)));
                    w.z = cvt_pk_bf16(v1[0] * s1[0] * silu_f(bf_lo(z.z)), v1[1] * s1[1] * silu_f(bf_hi(z.z)));
                    w.w = cvt_pk_bf16(v1[2] * s1[2] * silu_f(bf_lo(z.w)), v1[3] * s1[3] * silu_f(bf_hi(z.w)));
                    *(u32x4*)(O + row * DM + col0 + bj * HALF) = w; asm volatile("" ::: "memory"); }
        }
    }
};
struct EpiGate {
    static constexpr bool PERM = true, MID = true;
    const bf16_t* proj; const float* gate_b; bf16_t* O;
    __device__ __forceinline__ void mid(f32x4 (&acc)[2][2][4][2], const Unit& u, int wr, int wc, int fr, int fq) const {
        int row0 = u.pm * BM + wr * 64 + fr, col0 = u.pn * BM + wc * 32 + 8 * fq;
        asm volatile("" : "+v"(row0), "+v"(col0));
#pragma unroll
        for (int bj = 0; bj < 2; ++bj) {
            const f32x4 b00 = *(const f32x4*)(gate_b + col0 + bj * HALF), b01 = *(const f32x4*)(gate_b + col0 + bj * HALF + 4);
            const f32x4 b10 = *(const f32x4*)(gate_b + DM + col0 + bj * HALF), b11 = *(const f32x4*)(gate_b + DM + col0 + bj * HALF + 4);
#pragma unroll
            for (int ai = 0; ai < 2; ++ai)
#pragma unroll
                for (int m = 0; m < 4; ++m) { const size_t row = (size_t)(row0 + ai * HALF + m * 16);
                    const bf16_t* p = proj + row * PROJW + C_GL + col0 + bj * HALF;
                    const u32x4 l0 = *(const u32x4*)p, l1 = *(const u32x4*)(p + DM);
                    f32x4 f0, f1;
#define GATE_F(x0, c0, x1, c1) ((1.0f + fast_exp_neg((x1) + (c1))) * __builtin_amdgcn_rcpf(1.0f + fast_exp_neg((x0) + (c0))))
                    f0[0] = GATE_F(bf_lo(l0.x), b00[0], bf_lo(l1.x), b10[0]); f0[1] = GATE_F(bf_hi(l0.x), b00[1], bf_hi(l1.x), b10[1]);
                    f0[2] = GATE_F(bf_lo(l0.y), b00[2], bf_lo(l1.y), b10[2]); f0[3] = GATE_F(bf_hi(l0.y), b00[3], bf_hi(l1.y), b10[3]);
                    f1[0] = GATE_F(bf_lo(l0.z), b01[0], bf_lo(l1.z), b11[0]); f1[1] = GATE_F(bf_hi(l0.z), b01[1], bf_hi(l1.z), b11[1]);
                    f1[2] = GATE_F(bf_lo(l0.w), b01[2], bf_lo(l1.w), b11[2]); f1[3] = GATE_F(bf_hi(l0.w), b01[3], bf_hi(l1.w), b11[3]);
#undef GATE_F
                    acc[ai][bj][m][0] = acc[ai][bj][m][0] * f0; acc[ai][bj][m][1] = acc[ai][bj][m][1] * f1;
                    asm volatile("" : "+v"(acc[ai][bj][m][0]), "+v"(acc[ai][bj][m][1]) :: "memory"); }
        }
    }
    __device__ __forceinline__ void operator()(const f32x4 (&acc)[2][2][4][2], const Unit& u, int wr, int wc, int fr, int fq) const {
        const int row0 = u.pm * BM + wr * 64 + fr, col0 = u.pn * BM + wc * 32 + 8 * fq;
#pragma unroll
        for (int bj = 0; bj < 2; ++bj) {
            const f32x4 b10 = *(const f32x4*)(gate_b + DM + col0 + bj * HALF), b11 = *(const f32x4*)(gate_b + DM + col0 + bj * HALF + 4);
#pragma unroll
            for (int ai = 0; ai < 2; ++ai)
#pragma unroll
                for (int m = 0; m < 4; ++m) { const size_t row = (size_t)(row0 + ai * HALF + m * 16);
                    const u32x4 l1 = *(const u32x4*)(proj + row * PROJW + C_GL + DM + col0 + bj * HALF);
                    const f32x4 v0 = acc[ai][bj][m][0], v1 = acc[ai][bj][m][1];
#define GATE_G(x1, c1) __builtin_amdgcn_rcpf(1.0f + fast_exp_neg((x1) + (c1)))
                    u32x4 w;
                    w.x = cvt_pk_bf16(v0[0] * GATE_G(bf_lo(l1.x), b10[0]), v0[1] * GATE_G(bf_hi(l1.x), b10[1]));
                    w.y = cvt_pk_bf16(v0[2] * GATE_G(bf_lo(l1.y), b10[2]), v0[3] * GATE_G(bf_hi(l1.y), b10[3]));
                    w.z = cvt_pk_bf16(v1[0] * GATE_G(bf_lo(l1.z), b11[0]), v1[1] * GATE_G(bf_hi(l1.z), b11[1]));
                    w.w = cvt_pk_bf16(v1[2] * GATE_G(bf_lo(l1.w), b11[2]), v1[3] * GATE_G(bf_hi(l1.w), b11[3]));
#undef GATE_G
                    *(u32x4*)(O + row * DM + col0 + bj * HALF) = w; asm volatile("" ::: "memory"); }
        }
    }
};
struct EpiResid {
    static constexpr bool PERM = true, MID = false;
    const float* x; float* out; float* part;
    __device__ __forceinline__ void mid(f32x4 (&)[2][2][4][2], const Unit&, int, int, int, int) const {}
    __device__ __forceinline__ void operator()(const f32x4 (&acc)[2][2][4][2], const Unit& u, int wr, int wc, int fr, int fq) const {
        const int row0 = u.pm * BM + wr * 64 + fr, col0 = u.pn * BM + wc * 32 + 8 * fq;
#pragma unroll
        for (int ai = 0; ai < 2; ++ai)
#pragma unroll
            for (int m = 0; m < 4; ++m) { const size_t row = (size_t)(row0 + ai * HALF + m * 16); float ss = 0.f;
#pragma unroll
                for (int bj = 0; bj < 2; ++bj) { const size_t off = row * DM + col0 + bj * HALF;
                    const f32x4 x0 = *(const f32x4*)(x + off), x1 = *(const f32x4*)(x + off + 4);
                    const f32x4 v0 = acc[ai][bj][m][0] + x0, v1 = acc[ai][bj][m][1] + x1;
                    *(f32x4*)(out + off) = v0; *(f32x4*)(out + off + 4) = v1;
                    ss += (v0[0] * v0[0] + v0[1] * v0[1]) + (v0[2] * v0[2] + v0[3] * v0[3]) + (v1[0] * v1[0] + v1[1] * v1[1]) + (v1[2] * v1[2] + v1[3] * v1[3]); }
                ss += __shfl_xor(ss, 16); ss += __shfl_xor(ss, 32);
                if (fq == 0) part[row * 64 + u.pn * 4 + wc] = ss; }
    }
};

template <class Epi, class Sched, bool ALIGN_EPI = false, bool SP2 = false>
__device__ __forceinline__ void gemm_phase(LAS unsigned char* lds, const Gemm g, const Sched& S, const Epi& E) {
    const int tid = threadIdx.x, wid = __builtin_amdgcn_readfirstlane(tid >> 6), lane = tid & 63, wr = wid >> 2, wc = wid & 3, fr = lane & 15, fq = lane >> 4;
    const int K = g.K, nt = K / BK;
    unsigned voffA[2], voffB[2];
#pragma unroll
    for (int i = 0; i < 2; ++i) { int R, C; stage_rc(tid * 16 + i * 8192, R, C); const int Rb = Epi::PERM ? ((R & ~31) + perm32(R & 31)) : R;
        voffA[i] = (unsigned)(R * g.lda + C) * 2u; voffB[i] = (unsigned)(Rb * g.ldb + C) * 2u; }
    const size_t kstep = (size_t)(BK * 2);
    const size_t hstepA = (size_t)HALF * g.lda * 2, hstepB = (size_t)HALF * g.ldb * 2;
    const size_t tstepA = 2 * hstepA, tstepB = 2 * hstepB;
    const unsigned ldsw = (unsigned)wid * 1024u;
    const int aoff = lds_byte(wr * 64 + fr, fq * 8), boff = lds_byte(wc * 32 + fr, fq * 8);
#define PG8_SA(b, h) (((b) * 2 + (h)) * HTB)
#define PG8_SB(b, h) ((4 + (b) * 2 + (h)) * HTB)
#define PG8_STAGE(bufoff, gbase, voff) do { _Pragma("unroll") for (int _i = 0; _i < 2; ++_i) \
        __builtin_amdgcn_global_load_lds((const unsigned*)((const char*)(gbase) + (voff)[_i]), (LAS unsigned*)(lds + (bufoff) + ldsw + _i * 8192), 16, 0, 0); } while (0)
#define PG8_LDA(dst, b, h) do { _Pragma("unroll") for (int m = 0; m < 4; ++m) _Pragma("unroll") for (int k = 0; k < 2; ++k) dst[m][k] = *(const LAS bf16x8*)(lds + PG8_SA(b, h) + aoff + m * 2048 + k * 1024); } while (0)
#define PG8_LDB(dst, b, h) do { _Pragma("unroll") for (int n = 0; n < 2; ++n) _Pragma("unroll") for (int k = 0; k < 2; ++k) dst[n][k] = *(const LAS bf16x8*)(lds + PG8_SB(b, h) + boff + n * 2048 + k * 1024); } while (0)
#define PG8_MMA(ai, bj, At, Bt) do { __builtin_amdgcn_s_setprio(1); _Pragma("unroll") for (int m = 0; m < 4; ++m) _Pragma("unroll") for (int n = 0; n < 2; ++n) _Pragma("unroll") for (int k = 0; k < 2; ++k) \
        acc[ai][bj][m][n] = __builtin_amdgcn_mfma_f32_16x16x32_bf16(Bt[n][k], At[m][k], acc[ai][bj][m][n], 0, 0, 0); __builtin_amdgcn_s_setprio(0); } while (0)
#define PG8_WAIT_V(n) asm volatile("s_waitcnt vmcnt(" #n ")" ::: "memory")
#define PG8_WAIT_L(n) asm volatile("s_waitcnt lgkmcnt(" #n ")" ::: "memory")
#define PG8_BAR __builtin_amdgcn_s_barrier()
#define PG8_SCHED __builtin_amdgcn_sched_barrier(0)
    Unit cur, nxt; int ui = 0;
    if (!S.next(0, cur)) return;
    f32x4 acc[2][2][4][2];
#pragma unroll
    for (int a = 0; a < 2; ++a)
#pragma unroll
        for (int b = 0; b < 2; ++b)
#pragma unroll
            for (int m = 0; m < 4; ++m)
#pragma unroll
                for (int n = 0; n < 2; ++n) acc[a][b][m][n] = (f32x4){0.f, 0.f, 0.f, 0.f};
    bf16x8 At[4][2], B0[2][2], B1[2][2];
    const char* cA = (const char*)g.A + (size_t)cur.pm * tstepA + (size_t)((cur.pn >> g.a_sh) * g.a_stride) * 2; const char* cB = (const char*)g.Bt + (size_t)cur.pn * tstepB;
    if constexpr (SP2) {
        PG8_STAGE(PG8_SB(0, 0), cB, voffB); PG8_STAGE(PG8_SB(0, 1), cB + hstepB, voffB); PG8_STAGE(PG8_SA(0, 0), cA, voffA); PG8_STAGE(PG8_SA(0, 1), cA + hstepA, voffA);
        if (wr == 1) PG8_BAR;
        PG8_WAIT_V(2); PG8_BAR;
        PG8_STAGE(PG8_SB(1, 0), cB + kstep, voffB); PG8_STAGE(PG8_SA(1, 0), cA + kstep, voffA); PG8_STAGE(PG8_SB(1, 1), cB + hstepB + kstep, voffB);
        PG8_WAIT_V(6); PG8_BAR;
    } else {
        PG8_STAGE(PG8_SB(0, 0), cB, voffB); PG8_STAGE(PG8_SA(0, 0), cA, voffA); PG8_STAGE(PG8_SB(0, 1), cB + hstepB, voffB); PG8_STAGE(PG8_SA(0, 1), cA + hstepA, voffA);
        if (wr == 1) PG8_BAR;
        PG8_WAIT_V(4); PG8_BAR;
        PG8_STAGE(PG8_SB(1, 0), cB + kstep, voffB); PG8_STAGE(PG8_SA(1, 0), cA + kstep, voffA); PG8_STAGE(PG8_SB(1, 1), cB + hstepB + kstep, voffB);
        PG8_WAIT_V(6); PG8_BAR;
    }
    for (;;) {
        const bool has_next = S.next(ui + 1, nxt);
        const char* nA = has_next ? (const char*)g.A + (size_t)nxt.pm * tstepA + (size_t)((nxt.pn >> g.a_sh) * g.a_stride) * 2 : cA; const char* nB = has_next ? (const char*)g.Bt + (size_t)nxt.pn * tstepB : cB;
        for (int t = 0; t < nt; t += 2) {
            const bool last = (t == nt - 2);
            const char* a1 = cA + (size_t)(t + 1) * kstep;
            const char* a2 = last ? nA : cA + (size_t)(t + 2) * kstep; const char* b2 = last ? nB : cB + (size_t)(t + 2) * kstep;
            const char* a3 = a2 + kstep; const char* b3 = b2 + kstep;
            if constexpr (Epi::MID) { if (t == (nt >> 1)) E.mid(acc, cur, wr, wc, fr, fq); }
            if constexpr (SP2) {
            PG8_LDB(B0, 0, 0); PG8_LDB(B1, 0, 1); PG8_SCHED; PG8_LDA(At, 0, 0); PG8_STAGE(PG8_SA(1, 1), a1 + hstepA, voffA);
            PG8_WAIT_V(8); PG8_WAIT_L(0); PG8_BAR; PG8_MMA(0, 0, At, B0); PG8_MMA(0, 1, At, B1); PG8_BAR; PG8_SCHED;
            PG8_LDA(At, 0, 1); PG8_STAGE(PG8_SB(0, 0), b2, voffB); PG8_STAGE(PG8_SB(0, 1), b2 + hstepB, voffB); PG8_STAGE(PG8_SA(0, 0), a2, voffA);
            PG8_WAIT_V(8); PG8_WAIT_L(0); PG8_BAR; PG8_MMA(1, 0, At, B0); PG8_MMA(1, 1, At, B1); PG8_BAR; PG8_SCHED;
            PG8_LDB(B0, 1, 0); PG8_LDB(B1, 1, 1); PG8_SCHED; PG8_LDA(At, 1, 0); PG8_STAGE(PG8_SA(0, 1), a2 + hstepA, voffA);
            PG8_WAIT_V(8); PG8_WAIT_L(0); PG8_BAR; PG8_MMA(0, 0, At, B0); PG8_MMA(0, 1, At, B1); PG8_BAR; PG8_SCHED;
            PG8_LDA(At, 1, 1); PG8_STAGE(PG8_SB(1, 0), b3, voffB); PG8_STAGE(PG8_SB(1, 1), b3 + hstepB, voffB); PG8_STAGE(PG8_SA(1, 0), a3, voffA);
            PG8_WAIT_V(8); PG8_WAIT_L(0); PG8_BAR; PG8_MMA(1, 0, At, B0); PG8_MMA(1, 1, At, B1); PG8_BAR; PG8_SCHED;
            } else {
            PG8_LDB(B0, 0, 0); PG8_SCHED; PG8_LDA(At, 0, 0); PG8_STAGE(PG8_SA(1, 1), a1 + hstepA, voffA);
            PG8_WAIT_L(8); PG8_BAR; PG8_WAIT_L(0); PG8_MMA(0, 0, At, B0); PG8_BAR; PG8_SCHED;
            PG8_LDB(B1, 0, 1); PG8_STAGE(PG8_SB(0, 0), b2, voffB);
            PG8_BAR; PG8_WAIT_L(0); PG8_MMA(0, 1, At, B1); PG8_BAR;
            PG8_LDA(At, 0, 1); PG8_STAGE(PG8_SA(0, 0), a2, voffA);
            PG8_BAR; PG8_WAIT_L(0); PG8_MMA(1, 0, At, B0); PG8_BAR; PG8_SCHED;
            PG8_STAGE(PG8_SB(0, 1), b2 + hstepB, voffB);
            PG8_WAIT_V(6); PG8_BAR; PG8_MMA(1, 1, At, B1); PG8_BAR;
            PG8_LDB(B0, 1, 0); PG8_SCHED; PG8_LDA(At, 1, 0); PG8_STAGE(PG8_SA(0, 1), a2 + hstepA, voffA);
            PG8_WAIT_L(8); PG8_BAR; PG8_WAIT_L(0); PG8_MMA(0, 0, At, B0); PG8_BAR; PG8_SCHED;
            PG8_LDB(B1, 1, 1); PG8_STAGE(PG8_SB(1, 0), b3, voffB);
            PG8_BAR; PG8_WAIT_L(0); PG8_MMA(0, 1, At, B1); PG8_BAR;
            PG8_LDA(At, 1, 1); PG8_STAGE(PG8_SA(1, 0), a3, voffA);
            PG8_BAR; PG8_WAIT_L(0); PG8_MMA(1, 0, At, B0); PG8_BAR; PG8_SCHED;
            PG8_STAGE(PG8_SB(1, 1), b3 + hstepB, voffB);
            PG8_WAIT_V(6); PG8_BAR; PG8_MMA(1, 1, At, B1); PG8_BAR;
            }
        }
        if constexpr (ALIGN_EPI) { if (wr == 0) PG8_BAR; }
        E(acc, cur, wr, wc, fr, fq);
        if (!has_next) break;
#pragma unroll
        for (int a = 0; a < 2; ++a)
#pragma unroll
            for (int b = 0; b < 2; ++b)
#pragma unroll
                for (int m = 0; m < 4; ++m)
#pragma unroll
                    for (int n = 0; n < 2; ++n) acc[a][b][m][n] = (f32x4){0.f, 0.f, 0.f, 0.f};
        cur = nxt; cA = nA; cB = nB; ++ui;
        if constexpr (ALIGN_EPI) { if (wr == 1) PG8_BAR; }
    }
    PG8_WAIT_V(0);
    if constexpr (!ALIGN_EPI) { if (wr == 0) PG8_BAR; }
    PG8_BAR;
#undef PG8_SA
#undef PG8_SB
#undef PG8_STAGE
#undef PG8_LDA
#undef PG8_LDB
#undef PG8_MMA
#undef PG8_WAIT_V
#undef PG8_WAIT_L
#undef PG8_BAR
#undef PG8_SCHED
}
}

constexpr int NWAVES = 8;
constexpr int N_LAUNCHES = MK_N_LAUNCHES;
constexpr int PER_PHASE = 7;

constexpr size_t MiB = 1u << 20;
constexpr size_t WS_CTL = 0, CTL_ZERO_BYTES = 1 * MiB;
constexpr size_t WS_WIN = 1 * MiB;
constexpr size_t WS_POOLED = 1 * MiB;
constexpr size_t WS_YS = 33 * MiB;
constexpr size_t WS_MERGED = 97 * MiB;
constexpr size_t WS_WBR = 161 * MiB;
constexpr size_t WS_WOUT = 193 * MiB;
constexpr size_t WS_PW = 225 * MiB;
constexpr size_t WS_PART = 227 * MiB;
constexpr size_t WS_H = 232 * MiB;
constexpr size_t WS_PROJ = 296 * MiB;
constexpr size_t WS_END = 616 * MiB;
constexpr int CW_BAR = 4096;

constexpr int RING_OFF = 0, RING_BYTES = 131072;
constexpr int LDSCTL_OFF = RING_BYTES, MISC_OFF = LDSCTL_OFF + 320;
constexpr int LDS_BYTES = 147456;

typedef GAS unsigned gu32;
#define RLX_AGENT __ATOMIC_RELAXED, __HIP_MEMORY_SCOPE_AGENT
#define LDS_WAIT() asm volatile("s_waitcnt lgkmcnt(0)" ::: "memory")
#define VM_WAIT() asm volatile("s_waitcnt vmcnt(0)" ::: "memory")
__device__ __forceinline__ unsigned f2bf(float f) { unsigned u = __builtin_bit_cast(unsigned, f); return (u + 0x7fffu + ((u >> 16) & 1u)) >> 16; }
__device__ __forceinline__ unsigned pk2(float lo, float hi) { return f2bf(lo) | (f2bf(hi) << 16); }

#define XB_TMO      128
#define XB_XCNT(j)  (256  + 64 * (j))
#define XB_XSUB(j)  (1280 + 64 * (j))
#define XB_XGEN(j)  (2304 + 64 * (j))
#define XB_TOP      3328
#define XB_TOPGEN   3392
#define XCD_BAR_WORDS 3456
#define XB_SPIN_CAP (1u << 18)

__device__ __forceinline__ unsigned xb_ld(unsigned* p)              { return __hip_atomic_load(p, __ATOMIC_RELAXED, __HIP_MEMORY_SCOPE_AGENT); }
__device__ __forceinline__ unsigned xb_add(unsigned* p, unsigned v) { return __hip_atomic_fetch_add(p, v, __ATOMIC_RELAXED, __HIP_MEMORY_SCOPE_AGENT); }
__device__ __forceinline__ unsigned xb_xcc_id() { return (unsigned)__builtin_amdgcn_s_getreg((3 << 11) | 20) & 0xFu; }
#define XB_SPIN(cond, bar) do { unsigned _sp = 0; while (cond) { __builtin_amdgcn_s_sleep(1); \
    if ((++_sp & 255u) == 0u) { if (xb_ld(&(bar)[XB_TMO])) break; if (_sp > XB_SPIN_CAP) { atomicAdd(&(bar)[XB_TMO], 1u); break; } } } } while (0)

struct XcdBarrier { unsigned* bar; unsigned x; volatile LAS unsigned* st; };

__device__ __forceinline__ XcdBarrier xcd_barrier_post(unsigned* bar, volatile LAS unsigned* st) {
    XcdBarrier b; b.bar = bar; b.x = xb_xcc_id(); b.st = st;
    if (threadIdx.x == 0) (void)xb_add(&bar[XB_XCNT(b.x)], 1u);
    return b;
}
__device__ __forceinline__ void xcd_barrier_complete(unsigned* bar, unsigned x, unsigned& nloc, unsigned& nx) {
    const unsigned G = gridDim.x * gridDim.y * gridDim.z;
    unsigned sum, cnt, mine, sp = 0u;
    for (;;) {
        sum = 0u; cnt = 0u; mine = 0u;
#pragma unroll
        for (unsigned j = 0; j < 16; ++j) { const unsigned c = xb_ld(&bar[XB_XCNT(j)]); sum += c; cnt += (c > 0u) ? 1u : 0u; mine = (j == x) ? c : mine; }
        if (sum == G) break;
        __builtin_amdgcn_s_sleep(1);
        if ((++sp & 255u) == 0u) { if (xb_ld(&bar[XB_TMO])) break; if (sp > XB_SPIN_CAP) { atomicAdd(&bar[XB_TMO], 1u); break; } }
    }
    nloc = mine > 0u ? mine : 1u; nx = cnt > 0u ? cnt : 1u;
}
__device__ __forceinline__ void xcd_barrier(const XcdBarrier& b) {
    asm volatile("s_waitcnt vmcnt(0)" ::: "memory");
    __syncthreads();
    if (threadIdx.x == 0) {
        unsigned* bar = b.bar;
        __builtin_amdgcn_s_waitcnt(0);
        unsigned nloc = b.st[0], nx = b.st[1];
        if (nloc == 0u) { xcd_barrier_complete(bar, b.x, nloc, nx); b.st[0] = nloc; b.st[1] = nx; }
        const unsigned old = xb_add(&bar[XB_XSUB(b.x)], 1u);
        const unsigned gen = old / nloc;
        if (old + 1u == (gen + 1u) * nloc) {
            __builtin_amdgcn_fence(__ATOMIC_RELEASE, "agent");
            asm volatile("s_waitcnt vmcnt(0)" ::: "memory");
            const unsigned og = xb_add(&bar[XB_TOP], 1u);
            const unsigned tg = og / nx;
            if (og + 1u == (tg + 1u) * nx) xb_add(&bar[XB_TOPGEN], 1u);
            else XB_SPIN(xb_ld(&bar[XB_TOPGEN]) == tg, bar);
            __builtin_amdgcn_fence(__ATOMIC_ACQUIRE, "agent");
            xb_add(&bar[XB_XGEN(b.x)], 1u);
            asm volatile("s_waitcnt vmcnt(0)" ::: "memory");
        } else {
            XB_SPIN(xb_ld(&bar[XB_XGEN(b.x)]) == gen, bar);
            __builtin_amdgcn_fence(__ATOMIC_ACQUIRE, "agent");
            asm volatile("s_waitcnt vmcnt(0)" ::: "memory");
        }
    }
    __syncthreads();
}

struct Frame {
    LAS unsigned char* lds;
    volatile LAS unsigned* MISC;
    gu32* ctl;
    int tid, lane, wave;
    int vcu, G;
    const float *x, *norm_w, *w_in, *pool_w, *pool_scale, *conv_w, *conv_b, *gate_b, *w_branch, *w_out, *final_w;
    float* out;
    bf16_t *WinT, *WbrT, *WoutT, *PwT, *H, *PROJ, *POOLED, *YS, *MERGED;
    float* PART;
};

__device__ __forceinline__ float wave_sum(float v) {
#pragma unroll
    for (int o = 1; o < 64; o <<= 1) v += __shfl_xor(v, o);
    return v;
}
__device__ __forceinline__ void p0_transpose_item(const float* W, int N, bf16_t* WT, int ldt, int row_off, int col_off, LAS float* scr, int item, int lane) {
    const int nblk = N / 32, kb = item / nblk, nb = item % nblk, k0 = 64 * kb, n0 = 32 * nb;
#pragma unroll 8
    for (int i = 0; i < 32; ++i) { const int kk = 2 * i + (lane >> 5); scr[kk * 33 + (lane & 31)] = W[(size_t)(k0 + kk) * N + n0 + (lane & 31)]; }
    LDS_WAIT(); asm volatile("" ::: "memory");
    const int c = lane & 7;
#pragma unroll
    for (int j = 0; j < 4; ++j) { const int n = (lane >> 3) + 8 * j; const LAS float* s = scr + (8 * c) * 33 + n;
        u32x4 o; o.x = pk2(s[0 * 33], s[1 * 33]); o.y = pk2(s[2 * 33], s[3 * 33]); o.z = pk2(s[4 * 33], s[5 * 33]); o.w = pk2(s[6 * 33], s[7 * 33]);
        *(GAS u32x4*)(WT + (size_t)(row_off + n0 + n) * ldt + col_off + k0 + 8 * c) = o; }
    LDS_WAIT(); asm volatile("" ::: "memory");
}
__device__ __forceinline__ void rms_row_to_bf16(Frame& F, const float* xrow, bf16_t* orow) {
    const GAS f32x4* xr = (const GAS f32x4*)xrow + F.lane; const GAS f32x4* wr4 = (const GAS f32x4*)F.norm_w + F.lane;
    f32x4 v[16]; float s = 0.f;
#pragma unroll
    for (int j = 0; j < 16; ++j) { v[j] = xr[64 * j]; s += (v[j].x * v[j].x + v[j].y * v[j].y) + (v[j].z * v[j].z + v[j].w * v[j].w); }
    const float rs = 1.0f / sqrtf(wave_sum(s) * (1.0f / DM) + NORM_EPS);
    GAS unsigned long long* o8 = (GAS unsigned long long*)orow + F.lane;
#pragma unroll
    for (int j = 0; j < 16; ++j) { const f32x4 w = wr4[64 * j];
        o8[64 * j] = (unsigned long long)pk2(v[j].x * rs * w.x, v[j].y * rs * w.y) | ((unsigned long long)pk2(v[j].z * rs * w.z, v[j].w * rs * w.w) << 32); }
}
__device__ __forceinline__ void p0_prologue(Frame& F) {
    LAS float* scr = (LAS float*)(F.lds + RING_OFF + F.wave * 16384);
    const int gw = F.vcu * NWAVES + F.wave, NGW = F.G * NWAVES;
    constexpr int I_IN = (DM / 64) * (PROJW / 32), I_BR = (PWID / 64) * (DM / 32), I_OUT = (DM / 64) * (DM / 32), I_PW = (PGD / 64) * (PGD / 32);
    constexpr int NITEMS = I_IN + 2 * I_BR + I_OUT + 4 * I_PW;
    for (int it = gw; it < NITEMS; it += NGW) {
        int r = it;
        if (r < I_IN) { p0_transpose_item(F.w_in, PROJW, F.WinT, DM, 0, 0, scr, r, F.lane); continue; } r -= I_IN;
        if (r < 2 * I_BR) { const int n = r / I_BR; p0_transpose_item(F.w_branch + (size_t)n * PWID * DM, DM, F.WbrT, DM, 0, n * PWID, scr, r - n * I_BR, F.lane); continue; } r -= 2 * I_BR;
        if (r < I_OUT) { p0_transpose_item(F.w_out, DM, F.WoutT, DM, 0, 0, scr, r, F.lane); continue; } r -= I_OUT;
        { const int gq = r / I_PW; p0_transpose_item(F.pool_w + (size_t)gq * PGD * PGD, PGD, F.PwT, PGD, gq * PGD, 0, scr, r - gq * I_PW, F.lane); }
    }
    for (int m = gw; m < MROWS; m += NGW) rms_row_to_bf16(F, F.x + (size_t)m * DM, F.H + (size_t)m * DM);
}

__device__ __forceinline__ void ld8(const bf16_t* p, float (&v)[8]) {
    const u32x4 w = *(const GAS u32x4*)p;
    v[0] = bf_lo(w.x); v[1] = bf_hi(w.x); v[2] = bf_lo(w.y); v[3] = bf_hi(w.y); v[4] = bf_lo(w.z); v[5] = bf_hi(w.z); v[6] = bf_lo(w.w); v[7] = bf_hi(w.w);
}
__device__ __forceinline__ void st8(bf16_t* p, const float (&v)[8]) {
    u32x4 w; w.x = pk2(v[0], v[1]); w.y = pk2(v[2], v[3]); w.z = pk2(v[4], v[5]); w.w = pk2(v[6], v[7]);
    *(GAS u32x4*)p = w;
}
__device__ __forceinline__ void p2a_phase(Frame& F) {
    constexpr int T = 16, NRB = MROWS / T;
    const int nthreads = F.G * NWAVES * 64, gtid = F.vcu * NWAVES * 64 + F.tid;
    for (int id = gtid; id < 2 * NRB * 256; id += nthreads) {
        const int cg = id & 255, rb = (id >> 8) & (NRB - 1), kind = id >> 17;
        const int c0 = cg * 8, row0 = rb * T, t0 = row0 & (SEQ - 1);
        if (kind == 0) {
            const int w = 2 << (c0 >> 9);
            const bf16_t* up = F.PROJ + (size_t)row0 * PROJW + C_UP + c0;
            float s[8];
#pragma unroll
            for (int j = 0; j < 8; ++j) s[j] = 0.f;
            if (t0 > 0) for (int i = 1; i < w; ++i) { float u[8]; ld8(up - (size_t)i * PROJW, u);
#pragma unroll
                for (int j = 0; j < 8; ++j) s[j] += u[j]; }
            for (int tt = 0; tt < T; ++tt) {
                float cur[8], o[8]; ld8(up + (size_t)tt * PROJW, cur);
                const int t = t0 + tt; const float inv = 1.0f / (float)((t + 1 < w) ? (t + 1) : w);
#pragma unroll
                for (int j = 0; j < 8; ++j) { s[j] += cur[j]; o[j] = s[j] * inv - cur[j]; }
                st8(F.POOLED + (size_t)(row0 + tt) * PWID + c0, o);
                if (t - (w - 1) >= 0) { float old[8]; ld8(up + ((ptrdiff_t)tt - (w - 1)) * PROJW, old);
#pragma unroll
                    for (int j = 0; j < 8; ++j) s[j] -= old[j]; }
            }
        } else {
            const bf16_t* base = F.PROJ + (size_t)row0 * PROJW + c0;
            float cw0[8], cw1[8], cw2[8], cb[8], v1[8], v2[8];
#pragma unroll
            for (int j = 0; j < 8; ++j) { cw0[j] = F.conv_w[c0 + j]; cw1[j] = F.conv_w[CWID + c0 + j]; cw2[j] = F.conv_w[2 * CWID + c0 + j]; cb[j] = F.conv_b[c0 + j]; v1[j] = 0.f; v2[j] = 0.f; }
            if (t0 > 0) { float u[8], c[8];
                ld8(base - (size_t)PROJW + C_UC, u); ld8(base - (size_t)PROJW + C_CG, c);
#pragma unroll
                for (int j = 0; j < 8; ++j) v1[j] = u[j] * c[j];
                ld8(base - (size_t)2 * PROJW + C_UC, u); ld8(base - (size_t)2 * PROJW + C_CG, c);
#pragma unroll
                for (int j = 0; j < 8; ++j) v2[j] = u[j] * c[j]; }
            for (int tt = 0; tt < T; ++tt) {
                const bf16_t* rp = base + (size_t)tt * PROJW;
                float u[8], c[8], b[8], z[8], o[8];
                ld8(rp + C_UC, u); ld8(rp + C_CG, c); ld8(rp + C_BG, b); ld8(rp + C_ZC, z);
#pragma unroll
                for (int j = 0; j < 8; ++j) { const float v0 = u[j] * c[j]; const float y = cb[j] + cw0[j] * v2[j] + cw1[j] * v1[j] + cw2[j] * v0;
                    o[j] = b[j] * y * silu_f(z[j]); v2[j] = v1[j]; v1[j] = v0; }
                st8(F.YS + (size_t)(row0 + tt) * DM + PWID + c0, o);
            }
        }
    }
}
__device__ __forceinline__ void p5_final(Frame& F) {
    const int gw = F.vcu * NWAVES + F.wave, NGW = F.G * NWAVES;
    const GAS f32x4* fw = (const GAS f32x4*)F.final_w + F.lane;
    for (int m = gw; m < MROWS; m += NGW) {
        const float ss = wave_sum(F.PART[(size_t)m * 64 + F.lane]);
        const float rs = 1.0f / sqrtf(ss * (1.0f / DM) + NORM_EPS);
        GAS f32x4* o = (GAS f32x4*)(F.out + (size_t)m * DM) + F.lane;
#pragma unroll
        for (int j = 0; j < 16; ++j) { const f32x4 v = o[64 * j], w = fw[64 * j]; o[64 * j] = v * rs * w; }
    }
}

struct Args { const float* in[11]; float* out; unsigned char* ws; int ph_lo, ph_hi, li, pad; };
__global__ void __launch_bounds__(NWAVES * 64, 2) hybrid_fwd(Args args) {
    extern __shared__ __attribute__((aligned(16))) unsigned char lds[];
    Frame F;
    F.lds = (LAS unsigned char*)lds;
    F.MISC = (volatile LAS unsigned*)(F.lds + MISC_OFF);
    F.tid = threadIdx.x; F.lane = F.tid & 63; F.wave = __builtin_amdgcn_readfirstlane(F.tid >> 6);
    F.G = gridDim.x; { const int bx = blockIdx.x; F.vcu = (F.G % 8 == 0) ? (bx % 8) * (F.G / 8) + bx / 8 : bx; }
    unsigned char* ws = args.ws;
    F.ctl = (gu32*)(ws + WS_CTL);
    F.x = args.in[0]; F.norm_w = args.in[1]; F.w_in = args.in[2]; F.pool_w = args.in[3]; F.pool_scale = args.in[4]; F.conv_w = args.in[5];
    F.conv_b = args.in[6]; F.gate_b = args.in[7]; F.w_branch = args.in[8]; F.w_out = args.in[9]; F.final_w = args.in[10]; F.out = args.out;
    F.WinT = (bf16_t*)(ws + WS_WIN); F.WbrT = (bf16_t*)(ws + WS_WBR); F.WoutT = (bf16_t*)(ws + WS_WOUT); F.PwT = (bf16_t*)(ws + WS_PW);
    F.H = (bf16_t*)(ws + WS_H); F.PROJ = (bf16_t*)(ws + WS_PROJ); F.POOLED = (bf16_t*)(ws + WS_POOLED); F.YS = (bf16_t*)(ws + WS_YS); F.MERGED = (bf16_t*)(ws + WS_MERGED);
    F.PART = (float*)(ws + WS_PART);
    for (int u = F.tid; u < (LDS_BYTES - LDSCTL_OFF) / 4; u += NWAVES * 64) ((LAS unsigned*)(F.lds + LDSCTL_OFF))[u] = 0u;
    __syncthreads();
    XcdBarrier bar; bar.bar = (unsigned*)(F.ctl + CW_BAR); bar.x = 0; bar.st = nullptr;
    if (N_LAUNCHES != PER_PHASE) bar = xcd_barrier_post((unsigned*)(F.ctl + CW_BAR), F.MISC + 8);
#define GRID_BAR() do { if (N_LAUNCHES != PER_PHASE) { xcd_barrier(bar); } } while (0)
    const int lo = args.ph_lo, hi = args.ph_hi;
#define IN(k) (lo <= (k) && (k) < hi)
#define BOTH(k) (IN(k) && IN((k) + 1))

    if (IN(0)) { p0_prologue(F); if (BOTH(0)) GRID_BAR(); }
    if (IN(1)) {
        pg8::Gemm g{F.H, F.WinT, DM, DM, DM, 0, 0}; pg8::StaticOrder S; S.init(MROWS, PROJW, F.G, (int)blockIdx.x);
        pg8::EpiStoreBf16 E{F.PROJ, PROJW};
        pg8::gemm_phase<pg8::EpiStoreBf16, pg8::StaticOrder, true, true>(F.lds + RING_OFF, g, S, E);
        if (BOTH(1)) GRID_BAR();
    }
    if (IN(2)) { p2a_phase(F); if (BOTH(2)) GRID_BAR(); }
    if (IN(3)) {
        pg8::Gemm g{F.POOLED, F.PwT, PWID, PGD, PGD, 1, PGD}; pg8::StaticOrder S; S.init(MROWS, PWID, F.G, (int)blockIdx.x);
        pg8::EpiPool E{F.PROJ, F.pool_scale, F.YS};
        pg8::gemm_phase<pg8::EpiPool, pg8::StaticOrder, true, true>(F.lds + RING_OFF, g, S, E);
        if (BOTH(3)) GRID_BAR();
    }
    if (IN(4)) {
        pg8::Gemm g{F.YS, F.WbrT, DM, DM, DM, 0, 0}; pg8::StaticOrder S; S.init(MROWS, DM, F.G, (int)blockIdx.x);
        pg8::EpiGate E{F.PROJ, F.gate_b, F.MERGED};
        pg8::gemm_phase<pg8::EpiGate, pg8::StaticOrder, true, true>(F.lds + RING_OFF, g, S, E);
        if (BOTH(4)) GRID_BAR();
    }
    if (IN(5)) {
        pg8::Gemm g{F.MERGED, F.WoutT, DM, DM, DM, 0, 0}; pg8::StaticOrder S; S.init(MROWS, DM, F.G, (int)blockIdx.x);
        pg8::EpiResid E{F.x, F.out, F.PART};
        pg8::gemm_phase<pg8::EpiResid, pg8::StaticOrder, true, true>(F.lds + RING_OFF, g, S, E);
        if (BOTH(5)) GRID_BAR();
    }
    if (IN(6)) { p5_final(F); }
#undef IN
#undef BOTH
}

extern "C" void kernel_launch(void* const* d_in, const int* in_sizes, int n_in, void* d_out, int out_size, void* d_ws, size_t ws_size, hipStream_t stream) {
    static int grid = 0;
    if (grid == 0) {
        if (n_in != 11 || in_sizes[0] != MROWS * DM || out_size != MROWS * DM || ws_size < WS_END) {
            fprintf(stderr, "kernel_launch: unexpected shapes / workspace: n_in %d in0 %d out %d ws %zu (need %zu); nothing launched\n", n_in, n_in > 0 ? in_sizes[0] : -1, out_size, ws_size, (size_t)WS_END); grid = -1; return; }
        int dev = 0, cus = 0, per_cu = 0;
        if (hipGetDevice(&dev) != hipSuccess || hipDeviceGetAttribute(&cus, hipDeviceAttributeMultiprocessorCount, dev) != hipSuccess) { grid = -1; return; }
        if (hipFuncSetAttribute((const void*)hybrid_fwd, hipFuncAttributeMaxDynamicSharedMemorySize, LDS_BYTES) != hipSuccess) { fprintf(stderr, "kernel_launch: hipFuncSetAttribute failed\n"); grid = -1; return; }
        if (hipOccupancyMaxActiveBlocksPerMultiprocessor(&per_cu, (const void*)hybrid_fwd, NWAVES * 64, LDS_BYTES) != hipSuccess || per_cu < 1) {
            fprintf(stderr, "kernel_launch: occupancy query reports %d workgroups per CU; nothing launched\n", per_cu); (void)hipGetLastError(); grid = -1; return; }
        (void)hipGetLastError();
        grid = cus;
    }
    if (grid < 0) return;
    if (hipMemsetAsync((char*)d_ws + WS_CTL, 0, CTL_ZERO_BYTES, stream) != hipSuccess) { fprintf(stderr, "kernel_launch: hipMemsetAsync failed\n"); return; }
    Args a{};
    for (int i = 0; i < 11; ++i) a.in[i] = (const float*)d_in[i];
    a.out = (float*)d_out; a.ws = (unsigned char*)d_ws;
    for (int li = 0; li < N_LAUNCHES; ++li) {
        a.ph_lo = (N_LAUNCHES == PER_PHASE) ? li : 0; a.ph_hi = (N_LAUNCHES == PER_PHASE) ? li + 1 : PER_PHASE; a.li = li;
        hipLaunchKernelGGL(hybrid_fwd, dim3(grid), dim3(NWAVES * 64), LDS_BYTES, stream, a);
        const hipError_t le = hipPeekAtLastError();
        if (le != hipSuccess) { fprintf(stderr, "kernel_launch: launch %d failed: %s\n", li, hipGetErrorName(le)); break; }
    }
}
```

```cpp
#include <hip/hip_runtime.h>
#include <cstdio>
#include <cstdint>

#ifndef MK_N_LAUNCHES
#define MK_N_LAUNCHES 1
#endif
#ifndef STAGGER_TICKS
#define STAGGER_TICKS 0
#endif
#ifndef DEBUG_DUMP
#define DEBUG_DUMP 0
#endif
#ifndef PROBE_DUP
#define PROBE_DUP -1
#endif

#define LAS __attribute__((address_space(3)))
#define GAS __attribute__((address_space(1)))
typedef unsigned short bf16_t;
typedef short bf16x8 __attribute__((ext_vector_type(8)));
typedef float f32x4 __attribute__((ext_vector_type(4)));
typedef unsigned u32x4 __attribute__((ext_vector_type(4)));
typedef unsigned u32x2 __attribute__((ext_vector_type(2)));

constexpr int DM = 4096, BATCH = 2, SEQ = 4096, MROWS = BATCH * SEQ;
constexpr int PWID = 2048, CWID = 2048, PGD = 512;
constexpr int PROJW = 20480;
constexpr int C_UP = 0, C_ZP = 2048, C_UC = 4096, C_BG = 6144, C_CG = 8192, C_ZC = 10240, C_GL = 12288;
constexpr float NORM_EPS = 1e-6f;

typedef float f32x2_t __attribute__((ext_vector_type(2)));
typedef __bf16 bf16x2_t __attribute__((ext_vector_type(2)));
__device__ __forceinline__ unsigned cvt_pk_bf16(float lo, float hi) { const f32x2_t v = {lo, hi}; return __builtin_bit_cast(unsigned, __builtin_convertvector(v, bf16x2_t)); }
__device__ __forceinline__ float bf_lo(unsigned w) { return __builtin_bit_cast(float, w << 16); }
__device__ __forceinline__ float bf_hi(unsigned w) { return __builtin_bit_cast(float, w & 0xffff0000u); }
__device__ __forceinline__ float fast_exp_neg(float x) { return __builtin_amdgcn_exp2f(x * -1.4426950408889634f); }
__device__ __forceinline__ float silu_f(float z) { return z * __builtin_amdgcn_rcpf(1.0f + fast_exp_neg(z)); }

namespace pg8 {
constexpr int BM = 256, BK = 64, HALF = 128, HTB = HALF * BK * 2, STAGE_BYTES = 8 * HTB, NXCD = 8, WGM = 8;
__host__ __device__ __forceinline__ int lds_byte(int r, int c) { const int st = (r >> 4) * 2 + (c >> 5), rr = r & 15, cc = c & 31, ob = rr * 64 + cc * 2; return st * 1024 + (ob ^ (((ob >> 9) & 1) << 5)); }
__host__ __device__ __forceinline__ void stage_rc(int b, int& R, int& C) { const int st = b / 1024, sb = b % 1024, swz = sb ^ (((sb >> 9) & 1) << 5); R = (st >> 1) * 16 + swz / 64; C = (st & 1) * 32 + (swz % 64) / 2; }
__host__ __device__ __forceinline__ int perm32(int rho) { const int n = rho >> 4, i = rho & 15; return 8 * (i >> 2) + 4 * n + (i & 3); }

struct Unit { int pm, pn; };
struct Gemm { const bf16_t* A; const bf16_t* Bt; int lda, ldb, K, a_sh, a_stride; };

struct StaticOrder {
    int nM, nN, nwg, G, c;
    __host__ __device__ void init(int M, int N, int G_, int c_) { nM = M / BM; nN = N / BM; nwg = nM * nN; G = G_; c = c_; }
    __host__ __device__ bool next(int i, Unit& u) const {
        const long L = (long)i * G + c; if (L >= nwg) return false;
        int wgid = (int)L; { const int q = nwg / NXCD, r = nwg % NXCD, xcd = wgid % NXCD, off = wgid / NXCD; wgid = (xcd < r ? xcd * (q + 1) : r * (q + 1) + (xcd - r) * q) + off; }
        const int nig = WGM * nN, gid = wgid / nig, fm = gid * WGM, gsz = (nM - fm) < WGM ? (nM - fm) : WGM;
        u.pm = fm + ((wgid % nig) % gsz); u.pn = (wgid % nig) / gsz; return true;
    }
};

struct SameTileOrder {
    int n;
    __host__ __device__ bool next(int i, Unit& u) const { if (i >= n) return false; u.pm = 0; u.pn = 0; return true; }
};


struct EpiStoreBf16 {
    static constexpr bool PERM = true, MID = false;
    bf16_t* O; int ldc;
    __device__ __forceinline__ void mid(f32x4 (&)[2][2][4][2], const Unit&, int, int, int, int) const {}
    __device__ __forceinline__ void operator()(const f32x4 (&acc)[2][2][4][2], const Unit& u, int wr, int wc, int fr, int fq) const {
        const int row0 = u.pm * BM + wr * 64 + fr, col0 = u.pn * BM + wc * 32 + 8 * fq;
#pragma unroll
        for (int ai = 0; ai < 2; ++ai)
#pragma unroll
            for (int m = 0; m < 4; ++m) { bf16_t* rowp = O + (size_t)(row0 + ai * HALF + m * 16) * ldc + col0;
#pragma unroll
                for (int bj = 0; bj < 2; ++bj) { const f32x4 v0 = acc[ai][bj][m][0], v1 = acc[ai][bj][m][1];
                    u32x4 w; w.x = cvt_pk_bf16(v0[0], v0[1]); w.y = cvt_pk_bf16(v0[2], v0[3]); w.z = cvt_pk_bf16(v1[0], v1[1]); w.w = cvt_pk_bf16(v1[2], v1[3]);
                    *(u32x4*)(rowp + bj * HALF) = w; } }
    }
};
struct EpiStoreTileDummy {
    static constexpr bool PERM = true, MID = false;
    bf16_t* O;
    __device__ __forceinline__ void mid(f32x4 (&)[2][2][4][2], const Unit&, int, int, int, int) const {}
    __device__ __forceinline__ void operator()(const f32x4 (&acc)[2][2][4][2], const Unit& u, int wr, int wc, int fr, int fq) const {
        bf16_t* T = O + (size_t)((u.pm * 80 + u.pn) & 1023) * 65536;
        const int row0 = wr * 64 + fr, col0 = wc * 32 + 8 * fq;
#pragma unroll
        for (int ai = 0; ai < 2; ++ai)
#pragma unroll
            for (int m = 0; m < 4; ++m) { bf16_t* rowp = T + (size_t)(row0 + ai * HALF + m * 16) * 256 + col0;
#pragma unroll
                for (int bj = 0; bj < 2; ++bj) { const f32x4 v0 = acc[ai][bj][m][0], v1 = acc[ai][bj][m][1];
                    if (PROBE_DUP == 15 && bj == 1) { asm volatile("" :: "v"(v0), "v"(v1)); continue; }
                    u32x4 w; w.x = cvt_pk_bf16(v0[0], v0[1]); w.y = cvt_pk_bf16(v0[2], v0[3]); w.z = cvt_pk_bf16(v1[0], v1[1]); w.w = cvt_pk_bf16(v1[2], v1[3]);
                    *(u32x4*)(rowp + bj * HALF) = w; } }
    }
};
struct EpiNone {
    static constexpr bool PERM = true, MID = false;
    __device__ __forceinline__ void mid(f32x4 (&)[2][2][4][2], const Unit&, int, int, int, int) const {}
    __device__ __forceinline__ void operator()(const f32x4 (&acc)[2][2][4][2], const Unit& u, int wr, int wc, int fr, int fq) const {
#pragma unroll
        for (int ai = 0; ai < 2; ++ai)
#pragma unroll
            for (int bj = 0; bj < 2; ++bj)
#pragma unroll
                for (int m = 0; m < 4; ++m)
#pragma unroll
                    for (int n = 0; n < 2; ++n) asm volatile("" :: "v"(acc[ai][bj][m][n]));
    }
};
__device__ __forceinline__ size_t frag_off(int ai, int m, int bj, int wid, int lane) { return (size_t)(((((ai * 4 + m) * 2 + bj) * 8 + wid) * 64 + lane) * 8); }
constexpr int FRAG_TILES_PER_PM = 40;

template <int CTRL> __device__ __forceinline__ float dpp_row(float x) { return __builtin_bit_cast(float, __builtin_amdgcn_update_dpp(0, __builtin_bit_cast(int, x), CTRL, 0xf, 0xf, true)); }

struct EpiProj {
    static constexpr bool PERM = true, MID = false;
    bf16_t* UP; bf16_t* FRAG; bf16_t* YS; float* REC_G; float* REC_Y; float* VLAST;
    const float* pscale; const float* conv_w; const float* conv_b; const float* gate_b;
    __device__ __forceinline__ void mid(f32x4 (&)[2][2][4][2], const Unit&, int, int, int, int) const {}
    __device__ __forceinline__ void operator()(const f32x4 (&acc)[2][2][4][2], const Unit& u, int wr, int wc, int fr_, int fq_) const {
        int fr = fr_, fq = fq_;
        asm volatile("" : "+v"(fr), "+v"(fq));
        const int wid = wr * 4 + wc, lane = fq * 16 + fr;
        if (u.pn < 8) {
            const int row0 = u.pm * BM + wr * 64 + fr, col0 = u.pn * BM + wc * 32 + 8 * fq;
#pragma unroll
            for (int ai = 0; ai < 2; ++ai)
#pragma unroll
                for (int m = 0; m < 4; ++m) { bf16_t* rowp = UP + (size_t)(row0 + ai * HALF + m * 16) * PWID + col0;
#pragma unroll
                    for (int bj = 0; bj < 2; ++bj) { const f32x4 v0 = acc[ai][bj][m][0], v1 = acc[ai][bj][m][1];
                        u32x4 w; w.x = cvt_pk_bf16(v0[0], v0[1]); w.y = cvt_pk_bf16(v0[2], v0[3]); w.z = cvt_pk_bf16(v1[0], v1[1]); w.w = cvt_pk_bf16(v1[2], v1[3]);
                        *(u32x4*)(rowp + bj * HALF) = w; } }
        } else if (u.pn < 16) {
            bf16_t* T = FRAG + (size_t)(u.pm * FRAG_TILES_PER_PM + (u.pn - 8)) * 65536;
            const int col0 = (u.pn - 8) * BM + wc * 32 + 8 * fq;
#pragma unroll
            for (int bj = 0; bj < 2; ++bj) {
                const f32x4 s0 = *(const f32x4*)(pscale + col0 + bj * HALF), s1 = *(const f32x4*)(pscale + col0 + bj * HALF + 4);
#pragma unroll
                for (int ai = 0; ai < 2; ++ai)
#pragma unroll
                    for (int m = 0; m < 4; ++m) { const f32x4 v0 = acc[ai][bj][m][0], v1 = acc[ai][bj][m][1];
                        u32x4 w;
                        w.x = cvt_pk_bf16(silu_f(v0[0]) * s0[0], silu_f(v0[1]) * s0[1]); w.y = cvt_pk_bf16(silu_f(v0[2]) * s0[2], silu_f(v0[3]) * s0[3]);
                        w.z = cvt_pk_bf16(silu_f(v1[0]) * s1[0], silu_f(v1[1]) * s1[1]); w.w = cvt_pk_bf16(silu_f(v1[2]) * s1[2], silu_f(v1[3]) * s1[3]);
                        *(u32x4*)(T + frag_off(ai, m, bj, wid, lane)) = w; }
            }
        } else if (u.pn < 48) {
            const int ch0 = 64 * (u.pn - 16) + 16 * wc + 4 * fq;
            const f32x4 w0 = *(const f32x4*)(conv_w + ch0), w1 = *(const f32x4*)(conv_w + CWID + ch0), w2 = *(const f32x4*)(conv_w + 2 * CWID + ch0), cb = *(const f32x4*)(conv_b + ch0);
#pragma unroll
            for (int ai = 0; ai < 2; ++ai) {
                f32x4 vprev = (f32x4){0.f, 0.f, 0.f, 0.f};
                const int blk = u.pm * 4 + ai * 2 + wr;
#pragma unroll
                for (int m = 0; m < 4; ++m) {
                    const f32x4 uu = acc[ai][0][m][0], bb = acc[ai][0][m][1], cc = acc[ai][1][m][0], zz = acc[ai][1][m][1];
                    const f32x4 v = cc * uu;
                    f32x4 g, y;
#pragma unroll
                    for (int j = 0; j < 4; ++j) {
                        const float p1 = dpp_row<0x111>(v[j]) + dpp_row<0x10F>(vprev[j]);
                        const float p2 = dpp_row<0x112>(v[j]) + dpp_row<0x10E>(vprev[j]);
                        g[j] = bb[j] * silu_f(zz[j]);
                        y[j] = cb[j] + w0[j] * p2 + w1[j] * p1 + w2[j] * v[j];
                    }
                    const size_t row = (size_t)(u.pm * BM + ai * HALF + wr * 64 + m * 16 + fr);
                    u32x2 o; o.x = cvt_pk_bf16(g[0] * y[0], g[1] * y[1]); o.y = cvt_pk_bf16(g[2] * y[2], g[3] * y[3]);
                    if (!(m == 0 && fr < 2)) *(u32x2*)(YS + row * DM + PWID + ch0) = o;
                    if (m == 0 && fr < 2) { const size_t ro = (size_t)(blk * 2 + fr) * CWID + ch0; *(f32x4*)(REC_G + ro) = g; *(f32x4*)(REC_Y + ro) = y; }
                    if (m == 3 && fr >= 14) { *(f32x4*)(VLAST + (size_t)(blk * 2 + fr - 14) * CWID + ch0) = v; }
                    vprev = v;
                }
            }
        } else {
            const int t = u.pn - 48;
            bf16_t* T = FRAG + (size_t)(u.pm * FRAG_TILES_PER_PM + 8 + t) * 65536;
            const int col0 = (t >> 4) * DM + (t & 15) * BM + wc * 32 + 8 * fq;
#pragma unroll
            for (int bj = 0; bj < 2; ++bj) {
                const f32x4 b0 = *(const f32x4*)(gate_b + col0 + bj * HALF), b1 = *(const f32x4*)(gate_b + col0 + bj * HALF + 4);
#pragma unroll
                for (int ai = 0; ai < 2; ++ai)
#pragma unroll
                    for (int m = 0; m < 4; ++m) { const f32x4 v0 = acc[ai][bj][m][0], v1 = acc[ai][bj][m][1];
                        u32x4 w;
                        w.x = cvt_pk_bf16(fast_exp_neg(v0[0] + b0[0]), fast_exp_neg(v0[1] + b0[1])); w.y = cvt_pk_bf16(fast_exp_neg(v0[2] + b0[2]), fast_exp_neg(v0[3] + b0[3]));
                        w.z = cvt_pk_bf16(fast_exp_neg(v1[0] + b1[0]), fast_exp_neg(v1[1] + b1[1])); w.w = cvt_pk_bf16(fast_exp_neg(v1[2] + b1[2]), fast_exp_neg(v1[3] + b1[3]));
                        *(u32x4*)(T + frag_off(ai, m, bj, wid, lane)) = w; }
            }
        }
    }
};
struct EpiPool {
    static constexpr bool PERM = true, MID = false;
    const bf16_t* FRAG; bf16_t* O;
    __device__ __forceinline__ void mid(f32x4 (&)[2][2][4][2], const Unit&, int, int, int, int) const {}
    __device__ __forceinline__ void operator()(const f32x4 (&acc)[2][2][4][2], const Unit& u, int wr, int wc, int fr_, int fq_) const {
        int fr = fr_, fq = fq_;
        asm volatile("" : "+v"(fr), "+v"(fq));
        const int wid = wr * 4 + wc, lane = fq * 16 + fr;
        const int row0 = u.pm * BM + wr * 64 + fr, col0 = u.pn * BM + wc * 32 + 8 * fq;
        const bf16_t* T = FRAG + (size_t)(u.pm * FRAG_TILES_PER_PM + u.pn) * 65536;
#pragma unroll
        for (int ai = 0; ai < 2; ++ai)
#pragma unroll
            for (int m = 0; m < 4; ++m) { const size_t row = (size_t)(row0 + ai * HALF + m * 16);
#pragma unroll
                for (int bj = 0; bj < 2; ++bj) {
                    const u32x4 z = *(const u32x4*)(T + frag_off(ai, m, bj, wid, lane));
                    const f32x4 v0 = acc[ai][bj][m][0], v1 = acc[ai][bj][m][1];
                    u32x4 w;
                    w.x = cvt_pk_bf16(v0[0] * bf_lo(z.x), v0[1] * bf_hi(z.x)); w.y = cvt_pk_bf16(v0[2] * bf_lo(z.y), v0[3] * bf_hi(z.y));
                    w.z = cvt_pk_bf16(v1[0] * bf_lo(z.z), v1[1] * bf_hi(z.z)); w.w = cvt_pk_bf16(v1[2] * bf_lo(z.w), v1[3] * bf_hi(z.w));
                    *(u32x4*)(O + row * DM + col0 + bj * HALF) = w; }
                asm volatile("" ::: "memory"); }
    }
};
struct EpiGate {
    static constexpr bool PERM = true, MID = true;
    const bf16_t* FRAG; bf16_t* O;
    __device__ __forceinline__ void mid(f32x4 (&acc)[2][2][4][2], const Unit& u, int wr, int wc, int fr, int fq) const {
        int wid = wr * 4 + wc, lane = fq * 16 + fr;
        asm volatile("" : "+v"(lane));
        const bf16_t* T0 = FRAG + (size_t)(u.pm * FRAG_TILES_PER_PM + 8 + u.pn) * 65536; const bf16_t* T1 = T0 + (size_t)16 * 65536;
#pragma unroll
        for (int ai = 0; ai < 2; ++ai)
#pragma unroll
            for (int m = 0; m < 4; ++m) {
#pragma unroll
                for (int bj = 0; bj < 2; ++bj) { const size_t fo = frag_off(ai, m, bj, wid, lane);
                    const u32x4 e0 = *(const u32x4*)(T0 + fo), e1 = *(const u32x4*)(T1 + fo);
                    f32x4 f0, f1;
#define GATE_F(x0, x1) ((1.0f + (x1)) * __builtin_amdgcn_rcpf(1.0f + (x0)))
                    f0[0] = GATE_F(bf_lo(e0.x), bf_lo(e1.x)); f0[1] = GATE_F(bf_hi(e0.x), bf_hi(e1.x)); f0[2] = GATE_F(bf_lo(e0.y), bf_lo(e1.y)); f0[3] = GATE_F(bf_hi(e0.y), bf_hi(e1.y));
                    f1[0] = GATE_F(bf_lo(e0.z), bf_lo(e1.z)); f1[1] = GATE_F(bf_hi(e0.z), bf_hi(e1.z)); f1[2] = GATE_F(bf_lo(e0.w), bf_lo(e1.w)); f1[3] = GATE_F(bf_hi(e0.w), bf_hi(e1.w));
#undef GATE_F
                    acc[ai][bj][m][0] = acc[ai][bj][m][0] * f0; acc[ai][bj][m][1] = acc[ai][bj][m][1] * f1; }
                asm volatile("" : "+v"(acc[ai][0][m][0]), "+v"(acc[ai][0][m][1]), "+v"(acc[ai][1][m][0]), "+v"(acc[ai][1][m][1]) :: "memory"); }
    }
    __device__ __forceinline__ void operator()(const f32x4 (&acc)[2][2][4][2], const Unit& u, int wr, int wc, int fr_, int fq_) const {
        int fr = fr_, fq = fq_;
        asm volatile("" : "+v"(fr), "+v"(fq));
        const int wid = wr * 4 + wc, lane = fq * 16 + fr;
        const int row0 = u.pm * BM + wr * 64 + fr, col0 = u.pn * BM + wc * 32 + 8 * fq;
        const bf16_t* T1 = FRAG + (size_t)(u.pm * FRAG_TILES_PER_PM + 8 + 16 + u.pn) * 65536;
#pragma unroll
        for (int ai = 0; ai < 2; ++ai)
#pragma unroll
            for (int m = 0; m < 4; ++m) { const size_t row = (size_t)(row0 + ai * HALF + m * 16);
#pragma unroll
                for (int bj = 0; bj < 2; ++bj) {
                    const u32x4 e1 = *(const u32x4*)(T1 + frag_off(ai, m, bj, wid, lane));
                    const f32x4 v0 = acc[ai][bj][m][0], v1 = acc[ai][bj][m][1];
#define GATE_G(x1) __builtin_amdgcn_rcpf(1.0f + (x1))
                    u32x4 w;
                    w.x = cvt_pk_bf16(v0[0] * GATE_G(bf_lo(e1.x)), v0[1] * GATE_G(bf_hi(e1.x))); w.y = cvt_pk_bf16(v0[2] * GATE_G(bf_lo(e1.y)), v0[3] * GATE_G(bf_hi(e1.y)));
                    w.z = cvt_pk_bf16(v1[0] * GATE_G(bf_lo(e1.z)), v1[1] * GATE_G(bf_hi(e1.z))); w.w = cvt_pk_bf16(v1[2] * GATE_G(bf_lo(e1.w)), v1[3] * GATE_G(bf_hi(e1.w)));
#undef GATE_G
                    *(u32x4*)(O + row * DM + col0 + bj * HALF) = w; }
                asm volatile("" ::: "memory"); }
    }
};
struct EpiResid {
    static constexpr bool PERM = true, MID = false;
    const float* x; float* out; float* part;
    __device__ __forceinline__ void mid(f32x4 (&)[2][2][4][2], const Unit&, int, int, int, int) const {}
    __device__ __forceinline__ void operator()(const f32x4 (&acc)[2][2][4][2], const Unit& u, int wr, int wc, int fr, int fq) const {
        const int row0 = u.pm * BM + wr * 64 + fr, col0 = u.pn * BM + wc * 32 + 8 * fq;
#pragma unroll
        for (int ai = 0; ai < 2; ++ai)
#pragma unroll
            for (int m = 0; m < 4; ++m) { const size_t row = (size_t)(row0 + ai * HALF + m * 16); float ss = 0.f;
#pragma unroll
                for (int bj = 0; bj < 2; ++bj) { const size_t off = row * DM + col0 + bj * HALF;
                    const f32x4 x0 = *(const f32x4*)(x + off), x1 = *(const f32x4*)(x + off + 4);
                    const f32x4 v0 = acc[ai][bj][m][0] + x0, v1 = acc[ai][bj][m][1] + x1;
                    *(f32x4*)(out + off) = v0; *(f32x4*)(out + off + 4) = v1;
                    ss += (v0[0] * v0[0] + v0[1] * v0[1]) + (v0[2] * v0[2] + v0[3] * v0[3]) + (v1[0] * v1[0] + v1[1] * v1[1]) + (v1[2] * v1[2] + v1[3] * v1[3]); }
                ss += __shfl_xor(ss, 16); ss += __shfl_xor(ss, 32);
                if (fq == 0) part[row * 64 + u.pn * 4 + wc] = ss; }
    }
};

template <class Epi, class Sched, bool ALIGN_EPI = false, bool SP2 = false, int ABL = 0  >
__device__ __forceinline__ void gemm_phase(LAS unsigned char* lds, const Gemm g, const Sched& S, const Epi& E) {
    const int tid = threadIdx.x, wid = __builtin_amdgcn_readfirstlane(tid >> 6), lane = tid & 63, wr = wid >> 2, wc = wid & 3, fr = lane & 15, fq = lane >> 4;
    const int K = g.K, nt = K / BK;
    unsigned voffA[2], voffB[2];
#pragma unroll
    for (int i = 0; i < 2; ++i) { int R, C; stage_rc(tid * 16 + i * 8192, R, C); const int Rb = Epi::PERM ? ((R & ~31) + perm32(R & 31)) : R;
        voffA[i] = (unsigned)(R * g.lda + C) * 2u; voffB[i] = (unsigned)(Rb * g.ldb + C) * 2u; }
    const size_t kstep = (size_t)(BK * 2);
    const size_t hstepA = (size_t)HALF * g.lda * 2, hstepB = (size_t)HALF * g.ldb * 2;
    const size_t tstepA = 2 * hstepA, tstepB = 2 * hstepB;
    const unsigned ldsw = (unsigned)wid * 1024u;
    const int aoff = lds_byte(wr * 64 + fr, fq * 8), boff = lds_byte(wc * 32 + fr, fq * 8);
#define PG8_SA(b, h) (((b) * 2 + (h)) * HTB)
#define PG8_SB(b, h) ((4 + (b) * 2 + (h)) * HTB)
#define PG8_STAGE(bufoff, gbase, voff) do { if (ABL != 2 || !in_loop) _Pragma("unroll") for (int _i = 0; _i < 2; ++_i) \
        __builtin_amdgcn_global_load_lds((const unsigned*)((const char*)(gbase) + (voff)[_i]), (LAS unsigned*)(lds + (bufoff) + ldsw + _i * 8192), 16, 0, 0); } while (0)
#define PG8_LDA(dst, b, h) do { if (ABL != 1 || first_kt) _Pragma("unroll") for (int m = 0; m < 4; ++m) _Pragma("unroll") for (int k = 0; k < 2; ++k) dst[m][k] = *(const LAS bf16x8*)(lds + PG8_SA(b, h) + aoff + m * 2048 + k * 1024); } while (0)
#define PG8_LDB(dst, b, h) do { if (ABL != 1 || first_kt) _Pragma("unroll") for (int n = 0; n < 2; ++n) _Pragma("unroll") for (int k = 0; k < 2; ++k) dst[n][k] = *(const LAS bf16x8*)(lds + PG8_SB(b, h) + boff + n * 2048 + k * 1024); } while (0)
#define PG8_MMA(ai, bj, At, Bt) do { __builtin_amdgcn_s_setprio(1); _Pragma("unroll") for (int m = 0; m < 4; ++m) _Pragma("unroll") for (int n = 0; n < 2; ++n) _Pragma("unroll") for (int k = 0; k < 2; ++k) \
        acc[ai][bj][m][n] = __builtin_amdgcn_mfma_f32_16x16x32_bf16(Bt[n][k], At[m][k], acc[ai][bj][m][n], 0, 0, 0); __builtin_amdgcn_s_setprio(0); } while (0)
#define PG8_WAIT_V(n) asm volatile("s_waitcnt vmcnt(" #n ")" ::: "memory")
#define PG8_WAIT_L(n) asm volatile("s_waitcnt lgkmcnt(" #n ")" ::: "memory")
#define PG8_BAR __builtin_amdgcn_s_barrier()
#define PG8_SCHED __builtin_amdgcn_sched_barrier(0)
    Unit cur, nxt; int ui = 0;
    bool in_loop = false, first_kt = true;
    if (!S.next(0, cur)) return;
    f32x4 acc[2][2][4][2];
#pragma unroll
    for (int a = 0; a < 2; ++a)
#pragma unroll
        for (int b = 0; b < 2; ++b)
#pragma unroll
            for (int m = 0; m < 4; ++m)
#pragma unroll
                for (int n = 0; n < 2; ++n) acc[a][b][m][n] = (f32x4){0.f, 0.f, 0.f, 0.f};
    bf16x8 At[4][2], B0[2][2], B1[2][2];
    const char* cA = (const char*)g.A + (size_t)cur.pm * tstepA + (size_t)((cur.pn >> g.a_sh) * g.a_stride) * 2; const char* cB = (const char*)g.Bt + (size_t)cur.pn * tstepB;
    if constexpr (SP2) {
        PG8_STAGE(PG8_SB(0, 0), cB, voffB); PG8_STAGE(PG8_SB(0, 1), cB + hstepB, voffB); PG8_STAGE(PG8_SA(0, 0), cA, voffA); PG8_STAGE(PG8_SA(0, 1), cA + hstepA, voffA);
        if (wr == 1) PG8_BAR;
        PG8_WAIT_V(2); PG8_BAR;
        PG8_STAGE(PG8_SB(1, 0), cB + kstep, voffB); PG8_STAGE(PG8_SA(1, 0), cA + kstep, voffA); PG8_STAGE(PG8_SB(1, 1), cB + hstepB + kstep, voffB);
        PG8_WAIT_V(6); PG8_BAR;
    } else {
        PG8_STAGE(PG8_SB(0, 0), cB, voffB); PG8_STAGE(PG8_SA(0, 0), cA, voffA); PG8_STAGE(PG8_SB(0, 1), cB + hstepB, voffB); PG8_STAGE(PG8_SA(0, 1), cA + hstepA, voffA);
        if (wr == 1) PG8_BAR;
        PG8_WAIT_V(4); PG8_BAR;
        PG8_STAGE(PG8_SB(1, 0), cB + kstep, voffB); PG8_STAGE(PG8_SA(1, 0), cA + kstep, voffA); PG8_STAGE(PG8_SB(1, 1), cB + hstepB + kstep, voffB);
        PG8_WAIT_V(6); PG8_BAR;
    }
    for (;;) {
        const bool has_next = S.next(ui + 1, nxt);
        const char* nA = has_next ? (const char*)g.A + (size_t)nxt.pm * tstepA + (size_t)((nxt.pn >> g.a_sh) * g.a_stride) * 2 : cA; const char* nB = has_next ? (const char*)g.Bt + (size_t)nxt.pn * tstepB : cB;
        for (int t = 0; t < nt; t += 2) {
            const bool last = (t == nt - 2);
            in_loop = true; first_kt = (ui == 0 && t == 0);
            const char* a1 = cA + (size_t)(t + 1) * kstep;
            const char* a2 = last ? nA : cA + (size_t)(t + 2) * kstep; const char* b2 = last ? nB : cB + (size_t)(t + 2) * kstep;
            const char* a3 = a2 + kstep; const char* b3 = b2 + kstep;
            if constexpr (Epi::MID) { if (t == (nt >> 1)) E.mid(acc, cur, wr, wc, fr, fq); }
            if constexpr (SP2) {
            PG8_LDB(B0, 0, 0); PG8_LDB(B1, 0, 1); PG8_SCHED; PG8_LDA(At, 0, 0); PG8_STAGE(PG8_SA(1, 1), a1 + hstepA, voffA);
            PG8_WAIT_V(8); PG8_WAIT_L(0); PG8_BAR; PG8_MMA(0, 0, At, B0); PG8_MMA(0, 1, At, B1); PG8_BAR; PG8_SCHED;
            PG8_LDA(At, 0, 1); PG8_STAGE(PG8_SB(0, 0), b2, voffB); PG8_STAGE(PG8_SB(0, 1), b2 + hstepB, voffB); PG8_STAGE(PG8_SA(0, 0), a2, voffA);
            PG8_WAIT_V(8); PG8_WAIT_L(0); PG8_BAR; PG8_MMA(1, 0, At, B0); PG8_MMA(1, 1, At, B1); PG8_BAR; PG8_SCHED;
            PG8_LDB(B0, 1, 0); PG8_LDB(B1, 1, 1); PG8_SCHED; PG8_LDA(At, 1, 0); PG8_STAGE(PG8_SA(0, 1), a2 + hstepA, voffA);
            PG8_WAIT_V(8); PG8_WAIT_L(0); PG8_BAR; PG8_MMA(0, 0, At, B0); PG8_MMA(0, 1, At, B1); PG8_BAR; PG8_SCHED;
            PG8_LDA(At, 1, 1); PG8_STAGE(PG8_SB(1, 0), b3, voffB); PG8_STAGE(PG8_SB(1, 1), b3 + hstepB, voffB); PG8_STAGE(PG8_SA(1, 0), a3, voffA);
            PG8_WAIT_V(8); PG8_WAIT_L(0); PG8_BAR; PG8_MMA(1, 0, At, B0); PG8_MMA(1, 1, At, B1); PG8_BAR; PG8_SCHED;
            } else {
            PG8_LDB(B0, 0, 0); PG8_SCHED; PG8_LDA(At, 0, 0); PG8_STAGE(PG8_SA(1, 1), a1 + hstepA, voffA);
            PG8_WAIT_L(8); PG8_BAR; PG8_WAIT_L(0); PG8_MMA(0, 0, At, B0); PG8_BAR; PG8_SCHED;
            PG8_LDB(B1, 0, 1); PG8_STAGE(PG8_SB(0, 0), b2, voffB);
            PG8_BAR; PG8_WAIT_L(0); PG8_MMA(0, 1, At, B1); PG8_BAR;
            PG8_LDA(At, 0, 1); PG8_STAGE(PG8_SA(0, 0), a2, voffA);
            PG8_BAR; PG8_WAIT_L(0); PG8_MMA(1, 0, At, B0); PG8_BAR; PG8_SCHED;
            PG8_STAGE(PG8_SB(0, 1), b2 + hstepB, voffB);
            PG8_WAIT_V(6); PG8_BAR; PG8_MMA(1, 1, At, B1); PG8_BAR;
            PG8_LDB(B0, 1, 0); PG8_SCHED; PG8_LDA(At, 1, 0); PG8_STAGE(PG8_SA(0, 1), a2 + hstepA, voffA);
            PG8_WAIT_L(8); PG8_BAR; PG8_WAIT_L(0); PG8_MMA(0, 0, At, B0); PG8_BAR; PG8_SCHED;
            PG8_LDB(B1, 1, 1); PG8_STAGE(PG8_SB(1, 0), b3, voffB);
            PG8_BAR; PG8_WAIT_L(0); PG8_MMA(0, 1, At, B1); PG8_BAR;
            PG8_LDA(At, 1, 1); PG8_STAGE(PG8_SA(1, 0), a3, voffA);
            PG8_BAR; PG8_WAIT_L(0); PG8_MMA(1, 0, At, B0); PG8_BAR; PG8_SCHED;
            PG8_STAGE(PG8_SB(1, 1), b3 + hstepB, voffB);
            PG8_WAIT_V(6); PG8_BAR; PG8_MMA(1, 1, At, B1); PG8_BAR;
            }
        }
        if constexpr (ALIGN_EPI) { if (wr == 0) PG8_BAR; }
        E(acc, cur, wr, wc, fr, fq);
        if (!has_next) break;
#pragma unroll
        for (int a = 0; a < 2; ++a)
#pragma unroll
            for (int b = 0; b < 2; ++b)
#pragma unroll
                for (int m = 0; m < 4; ++m)
#pragma unroll
                    for (int n = 0; n < 2; ++n) acc[a][b][m][n] = (f32x4){0.f, 0.f, 0.f, 0.f};
        cur = nxt; cA = nA; cB = nB; ++ui;
        if constexpr (ALIGN_EPI) { if (wr == 1) PG8_BAR; }
    }
    PG8_WAIT_V(0);
    if constexpr (!ALIGN_EPI) { if (wr == 0) PG8_BAR; }
    PG8_BAR;
#undef PG8_SA
#undef PG8_SB
#undef PG8_STAGE
#undef PG8_LDA
#undef PG8_LDB
#undef PG8_MMA
#undef PG8_WAIT_V
#undef PG8_WAIT_L
#undef PG8_BAR
#undef PG8_SCHED
}
}

constexpr int NWAVES = 8;
constexpr int N_LAUNCHES = MK_N_LAUNCHES;
constexpr int PER_PHASE = 7;

constexpr size_t MiB = 1u << 20;
constexpr size_t WS_CTL = 0, CTL_ZERO_BYTES = 1 * MiB;
constexpr size_t WS_WIN = 1 * MiB;
constexpr size_t WS_POOLED = 1 * MiB;
constexpr size_t WS_MERGED = 33 * MiB;
constexpr size_t WS_WBR = 161 * MiB;
constexpr size_t WS_WOUT = 193 * MiB;
constexpr size_t WS_PW = 225 * MiB;
constexpr size_t WS_PART = 227 * MiB;
constexpr size_t WS_RECG = 229 * MiB;
constexpr size_t WS_RECY = 231 * MiB;
constexpr size_t WS_VLAST = 233 * MiB;
constexpr size_t WS_H = 236 * MiB;
constexpr size_t WS_UP = 300 * MiB;
constexpr size_t WS_FRAG = 332 * MiB;
constexpr size_t WS_YS = 492 * MiB;
constexpr size_t WS_END = 556 * MiB;
constexpr int CW_BAR = 4096;

constexpr int RING_OFF = 0, RING_BYTES = 131072;
constexpr int LDSCTL_OFF = RING_BYTES, MISC_OFF = LDSCTL_OFF + 320;
constexpr int LDS_BYTES = 147456;

typedef GAS unsigned gu32;
#define RLX_AGENT __ATOMIC_RELAXED, __HIP_MEMORY_SCOPE_AGENT
#define LDS_WAIT() asm volatile("s_waitcnt lgkmcnt(0)" ::: "memory")
#define VM_WAIT() asm volatile("s_waitcnt vmcnt(0)" ::: "memory")
__device__ __forceinline__ unsigned pk2(float lo, float hi) { return cvt_pk_bf16(lo, hi); }

#define XB_TMO      128
#define XB_XCNT(j)  (256  + 64 * (j))
#define XB_XSUB(j)  (1280 + 64 * (j))
#define XB_XGEN(j)  (2304 + 64 * (j))
#define XB_TOP      3328
#define XB_TOPGEN   3392
#define XCD_BAR_WORDS 3456
#define XB_SPIN_CAP (1u << 18)

__device__ __forceinline__ unsigned xb_ld(unsigned* p)              { return __hip_atomic_load(p, __ATOMIC_RELAXED, __HIP_MEMORY_SCOPE_AGENT); }
__device__ __forceinline__ unsigned xb_add(unsigned* p, unsigned v) { return __hip_atomic_fetch_add(p, v, __ATOMIC_RELAXED, __HIP_MEMORY_SCOPE_AGENT); }
__device__ __forceinline__ unsigned xb_xcc_id() { return (unsigned)__builtin_amdgcn_s_getreg((3 << 11) | 20) & 0xFu; }
#define XB_SPIN(cond, bar) do { unsigned _sp = 0; while (cond) { __builtin_amdgcn_s_sleep(1); \
    if ((++_sp & 255u) == 0u) { if (xb_ld(&(bar)[XB_TMO])) break; if (_sp > XB_SPIN_CAP) { atomicAdd(&(bar)[XB_TMO], 1u); break; } } } } while (0)

struct XcdBarrier { unsigned* bar; unsigned x; volatile LAS unsigned* st; };

__device__ __forceinline__ XcdBarrier xcd_barrier_post(unsigned* bar, volatile LAS unsigned* st) {
    XcdBarrier b; b.bar = bar; b.x = xb_xcc_id(); b.st = st;
    if (threadIdx.x == 0) (void)xb_add(&bar[XB_XCNT(b.x)], 1u);
    return b;
}
__device__ __forceinline__ void xcd_barrier_complete(unsigned* bar, unsigned x, unsigned& nloc, unsigned& nx) {
    const unsigned G = gridDim.x * gridDim.y * gridDim.z;
    unsigned sum, cnt, mine, sp = 0u;
    for (;;) {
        sum = 0u; cnt = 0u; mine = 0u;
#pragma unroll
        for (unsigned j = 0; j < 16; ++j) { const unsigned c = xb_ld(&bar[XB_XCNT(j)]); sum += c; cnt += (c > 0u) ? 1u : 0u; mine = (j == x) ? c : mine; }
        if (sum == G) break;
        __builtin_amdgcn_s_sleep(1);
        if ((++sp & 255u) == 0u) { if (xb_ld(&bar[XB_TMO])) break; if (sp > XB_SPIN_CAP) { atomicAdd(&bar[XB_TMO], 1u); break; } }
    }
    nloc = mine > 0u ? mine : 1u; nx = cnt > 0u ? cnt : 1u;
}
__device__ __forceinline__ void xcd_barrier(const XcdBarrier& b) {
    asm volatile("s_waitcnt vmcnt(0)" ::: "memory");
    __syncthreads();
    if (threadIdx.x == 0) {
        unsigned* bar = b.bar;
        __builtin_amdgcn_s_waitcnt(0);
        unsigned nloc = b.st[0], nx = b.st[1];
        if (nloc == 0u) { xcd_barrier_complete(bar, b.x, nloc, nx); b.st[0] = nloc; b.st[1] = nx; }
        const unsigned old = xb_add(&bar[XB_XSUB(b.x)], 1u);
        const unsigned gen = old / nloc;
        if (old + 1u == (gen + 1u) * nloc) {
            __builtin_amdgcn_fence(__ATOMIC_RELEASE, "agent");
            asm volatile("s_waitcnt vmcnt(0)" ::: "memory");
            const unsigned og = xb_add(&bar[XB_TOP], 1u);
            const unsigned tg = og / nx;
            if (og + 1u == (tg + 1u) * nx) xb_add(&bar[XB_TOPGEN], 1u);
            else XB_SPIN(xb_ld(&bar[XB_TOPGEN]) == tg, bar);
            __builtin_amdgcn_fence(__ATOMIC_ACQUIRE, "agent");
            xb_add(&bar[XB_XGEN(b.x)], 1u);
            asm volatile("s_waitcnt vmcnt(0)" ::: "memory");
        } else {
            XB_SPIN(xb_ld(&bar[XB_XGEN(b.x)]) == gen, bar);
            __builtin_amdgcn_fence(__ATOMIC_ACQUIRE, "agent");
            asm volatile("s_waitcnt vmcnt(0)" ::: "memory");
        }
    }
    __syncthreads();
}

struct Frame {
    LAS unsigned char* lds;
    volatile LAS unsigned* MISC;
    gu32* ctl;
    int tid, lane, wave;
    int vcu, G;
    const float *x, *norm_w, *w_in, *pool_w, *pool_scale, *conv_w, *conv_b, *gate_b, *w_branch, *w_out, *final_w;
    float* out;
    bf16_t *WinT, *WbrT, *WoutT, *PwT, *H, *UP, *FRAG, *POOLED, *YS, *MERGED;
    float *PART, *REC_G, *REC_Y, *VLAST;
};

__device__ __forceinline__ float wave_sum(float v) {
#pragma unroll
    for (int o = 1; o < 64; o <<= 1) v += __shfl_xor(v, o);
    return v;
}
__device__ __forceinline__ int win_dest_row(int e) {
    if (e < C_UC || e >= C_GL) return e;
    const int Q = (e - C_UC) >> 11, ch = (e - C_UC) & 2047, q = ch >> 6, cl = ch & 63;
    return 256 * (16 + q) + 128 * (Q >> 1) + 32 * (cl >> 4) + 8 * ((cl >> 2) & 3) + 4 * (Q & 1) + (cl & 3);
}
template <bool WIN_MAP>
__device__ __forceinline__ void p0_transpose_item(const float* W, int N, bf16_t* WT, int ldt, int row_off, int col_off, LAS float* scr, int item, int lane) {
    const int nblk = N / 32, kb = item / nblk, nb = item % nblk, k0 = 64 * kb, n0 = 32 * nb;
#pragma unroll 8
    for (int i = 0; i < 32; ++i) { const int kk = 2 * i + (lane >> 5); scr[kk * 33 + (lane & 31)] = W[(size_t)(k0 + kk) * N + n0 + (lane & 31)]; }
    LDS_WAIT(); asm volatile("" ::: "memory");
    const int c = lane & 7;
#pragma unroll
    for (int j = 0; j < 4; ++j) { const int n = (lane >> 3) + 8 * j; const LAS float* s = scr + (8 * c) * 33 + n;
        u32x4 o; o.x = pk2(s[0 * 33], s[1 * 33]); o.y = pk2(s[2 * 33], s[3 * 33]); o.z = pk2(s[4 * 33], s[5 * 33]); o.w = pk2(s[6 * 33], s[7 * 33]);
        const int drow = WIN_MAP ? win_dest_row(n0 + n) : (row_off + n0 + n);
        *(GAS u32x4*)(WT + (size_t)drow * ldt + col_off + k0 + 8 * c) = o; }
    LDS_WAIT(); asm volatile("" ::: "memory");
}
__device__ __forceinline__ void rms_row_to_bf16(Frame& F, const float* xrow, bf16_t* orow) {
    const GAS f32x4* xr = (const GAS f32x4*)xrow + F.lane; const GAS f32x4* wr4 = (const GAS f32x4*)F.norm_w + F.lane;
    f32x4 v[16]; float s = 0.f;
#pragma unroll
    for (int j = 0; j < 16; ++j) { v[j] = xr[64 * j]; s += (v[j].x * v[j].x + v[j].y * v[j].y) + (v[j].z * v[j].z + v[j].w * v[j].w); }
    const float rs = 1.0f / sqrtf(wave_sum(s) * (1.0f / DM) + NORM_EPS);
    GAS unsigned long long* o8 = (GAS unsigned long long*)orow + F.lane;
#pragma unroll
    for (int j = 0; j < 16; ++j) { const f32x4 w = wr4[64 * j];
        o8[64 * j] = (unsigned long long)pk2(v[j].x * rs * w.x, v[j].y * rs * w.y) | ((unsigned long long)pk2(v[j].z * rs * w.z, v[j].w * rs * w.w) << 32); }
}
__device__ __forceinline__ void p0_prologue(Frame& F) {
    LAS float* scr = (LAS float*)(F.lds + RING_OFF + F.wave * 16384);
    const int gw = F.vcu * NWAVES + F.wave, NGW = F.G * NWAVES;
    constexpr int I_IN = (DM / 64) * (PROJW / 32), I_BR = (PWID / 64) * (DM / 32), I_OUT = (DM / 64) * (DM / 32), I_PW = (PGD / 64) * (PGD / 32);
    constexpr int NITEMS = I_IN + 2 * I_BR + I_OUT + 4 * I_PW;
    for (int it = gw; it < NITEMS; it += NGW) {
        int r = it;
        if (r < I_IN) { p0_transpose_item<true>(F.w_in, PROJW, F.WinT, DM, 0, 0, scr, r, F.lane); continue; } r -= I_IN;
        if (r < 2 * I_BR) { const int n = r / I_BR; p0_transpose_item<false>(F.w_branch + (size_t)n * PWID * DM, DM, F.WbrT, DM, 0, n * PWID, scr, r - n * I_BR, F.lane); continue; } r -= 2 * I_BR;
        if (r < I_OUT) { p0_transpose_item<false>(F.w_out, DM, F.WoutT, DM, 0, 0, scr, r, F.lane); continue; } r -= I_OUT;
        { const int gq = r / I_PW; p0_transpose_item<false>(F.pool_w + (size_t)gq * PGD * PGD, PGD, F.PwT, PGD, gq * PGD, 0, scr, r - gq * I_PW, F.lane); }
    }
    for (int m = gw; m < MROWS; m += NGW) rms_row_to_bf16(F, F.x + (size_t)m * DM, F.H + (size_t)m * DM);
}

__device__ __forceinline__ void ld8(const bf16_t* p, float (&v)[8]) {
    const u32x4 w = *(const GAS u32x4*)p;
    v[0] = bf_lo(w.x); v[1] = bf_hi(w.x); v[2] = bf_lo(w.y); v[3] = bf_hi(w.y); v[4] = bf_lo(w.z); v[5] = bf_hi(w.z); v[6] = bf_lo(w.w); v[7] = bf_hi(w.w);
}
__device__ __forceinline__ void st8(bf16_t* p, const float (&v)[8]) {
    u32x4 w; w.x = pk2(v[0], v[1]); w.y = pk2(v[2], v[3]); w.z = pk2(v[4], v[5]); w.w = pk2(v[6], v[7]);
    *(GAS u32x4*)p = w;
}
__device__ __forceinline__ void ldf8(const float* p, float (&v)[8]) {
    const f32x4 a = *(const GAS f32x4*)p, b = *(const GAS f32x4*)(p + 4);
    v[0] = a[0]; v[1] = a[1]; v[2] = a[2]; v[3] = a[3]; v[4] = b[0]; v[5] = b[1]; v[6] = b[2]; v[7] = b[3];
}
__device__ __forceinline__ void p2a_phase(Frame& F) {
    constexpr int T = 16, NRB = MROWS / T;
    constexpr int NPOOL = NRB * 256, NFIX = 128 * 2 * 256;
    const int nthreads = F.G * NWAVES * 64, gtid = F.vcu * NWAVES * 64 + F.tid;
    for (int id = gtid; id < NPOOL + NFIX; id += nthreads) {
        if (id < NPOOL) {
            const int cg = id & 255, rb = id >> 8;
            const int c0 = cg * 8, row0 = rb * T, t0 = row0 & (SEQ - 1);
            const int w = 2 << (c0 >> 9);
            const bf16_t* up = F.UP + (size_t)row0 * PWID + c0;
            float s[8];
#pragma unroll
            for (int j = 0; j < 8; ++j) s[j] = 0.f;
            if (t0 > 0) for (int i = 1; i < w; ++i) { float u[8]; ld8(up - (size_t)i * PWID, u);
#pragma unroll
                for (int j = 0; j < 8; ++j) s[j] += u[j]; }
            for (int tt = 0; tt < T; ++tt) {
                float cur[8], o[8]; ld8(up + (size_t)tt * PWID, cur);
                const int t = t0 + tt; const float inv = 1.0f / (float)((t + 1 < w) ? (t + 1) : w);
#pragma unroll
                for (int j = 0; j < 8; ++j) { s[j] += cur[j]; o[j] = s[j] * inv - cur[j]; }
                st8(F.POOLED + (size_t)(row0 + tt) * PWID + c0, o);
                if (t - (w - 1) >= 0) { float old[8]; ld8(up + ((ptrdiff_t)tt - (w - 1)) * PWID, old);
#pragma unroll
                    for (int j = 0; j < 8; ++j) s[j] -= old[j]; }
            }
        } else {
            const int f = id - NPOOL; const int cg = f & 255, fr = (f >> 8) & 1, blk = f >> 9;
            const int c0 = cg * 8; const size_t ro = (size_t)(blk * 2 + fr) * CWID + c0;
            float g[8], y[8], o[8]; ldf8(F.REC_G + ro, g); ldf8(F.REC_Y + ro, y);
            if ((blk & 63) != 0) {
                float va[8], vb[8], w0[8], w1[8];
                ldf8(F.VLAST + (size_t)((blk - 1) * 2 + 0) * CWID + c0, va); ldf8(F.VLAST + (size_t)((blk - 1) * 2 + 1) * CWID + c0, vb);
                ldf8(F.conv_w + c0, w0); ldf8(F.conv_w + CWID + c0, w1);
#pragma unroll
                for (int j = 0; j < 8; ++j) y[j] += (fr == 0) ? (w0[j] * va[j] + w1[j] * vb[j]) : (w0[j] * vb[j]);
            }
#pragma unroll
            for (int j = 0; j < 8; ++j) o[j] = g[j] * y[j];
            st8(F.YS + (size_t)(blk * 64 + fr) * DM + PWID + c0, o);
        }
    }
}
__device__ __forceinline__ void p5_final(Frame& F) {
    const int gw = F.vcu * NWAVES + F.wave, NGW = F.G * NWAVES;
    const GAS f32x4* fw = (const GAS f32x4*)F.final_w + F.lane;
    for (int m = gw; m < MROWS; m += NGW) {
        const float ss = wave_sum(F.PART[(size_t)m * 64 + F.lane]);
        const float rs = 1.0f / sqrtf(ss * (1.0f / DM) + NORM_EPS);
        GAS f32x4* o = (GAS f32x4*)(F.out + (size_t)m * DM) + F.lane;
#pragma unroll
        for (int j = 0; j < 16; ++j) { const f32x4 v = o[64 * j], w = fw[64 * j]; o[64 * j] = v * rs * w; }
    }
}

struct Args { const float* in[11]; float* out; unsigned char* ws; int ph_lo, ph_hi, li, pad; };
__global__ void __launch_bounds__(NWAVES * 64, 2) hybrid_fwd(Args args) {
    extern __shared__ __attribute__((aligned(16))) unsigned char lds[];
    Frame F;
    F.lds = (LAS unsigned char*)lds;
    F.MISC = (volatile LAS unsigned*)(F.lds + MISC_OFF);
    F.tid = threadIdx.x; F.lane = F.tid & 63; F.wave = __builtin_amdgcn_readfirstlane(F.tid >> 6);
    F.G = gridDim.x; { const int bx = blockIdx.x; F.vcu = (F.G % 8 == 0) ? (bx % 8) * (F.G / 8) + bx / 8 : bx; }
    unsigned char* ws = args.ws;
    F.ctl = (gu32*)(ws + WS_CTL);
    F.x = args.in[0]; F.norm_w = args.in[1]; F.w_in = args.in[2]; F.pool_w = args.in[3]; F.pool_scale = args.in[4]; F.conv_w = args.in[5];
    F.conv_b = args.in[6]; F.gate_b = args.in[7]; F.w_branch = args.in[8]; F.w_out = args.in[9]; F.final_w = args.in[10]; F.out = args.out;
    F.WinT = (bf16_t*)(ws + WS_WIN); F.WbrT = (bf16_t*)(ws + WS_WBR); F.WoutT = (bf16_t*)(ws + WS_WOUT); F.PwT = (bf16_t*)(ws + WS_PW);
    F.H = (bf16_t*)(ws + WS_H); F.UP = (bf16_t*)(ws + WS_UP); F.FRAG = (bf16_t*)(ws + WS_FRAG); F.POOLED = (bf16_t*)(ws + WS_POOLED); F.YS = (bf16_t*)(ws + WS_YS); F.MERGED = (bf16_t*)(ws + WS_MERGED);
    F.PART = (float*)(ws + WS_PART); F.REC_G = (float*)(ws + WS_RECG); F.REC_Y = (float*)(ws + WS_RECY); F.VLAST = (float*)(ws + WS_VLAST);
    for (int u = F.tid; u < (LDS_BYTES - LDSCTL_OFF) / 4; u += NWAVES * 64) ((LAS unsigned*)(F.lds + LDSCTL_OFF))[u] = 0u;
    __syncthreads();
    XcdBarrier bar; bar.bar = (unsigned*)(F.ctl + CW_BAR); bar.x = 0; bar.st = nullptr;
    if (N_LAUNCHES != PER_PHASE) bar = xcd_barrier_post((unsigned*)(F.ctl + CW_BAR), F.MISC + 8);
#define GRID_BAR() do { if (N_LAUNCHES != PER_PHASE) { xcd_barrier(bar); } } while (0)
    const int lo = args.ph_lo, hi = args.ph_hi;
#define IN(k) (lo <= (k) && (k) < hi)
#define BOTH(k) (IN(k) && IN((k) + 1))

    if (IN(0)) { for (int rep = 0; rep < (PROBE_DUP == 0 ? 2 : 1); ++rep) p0_prologue(F); if (BOTH(0)) GRID_BAR(); }
    if (IN(1)) {
        pg8::Gemm g{F.H, F.WinT, DM, DM, DM, 0, 0}; pg8::StaticOrder S; S.init(MROWS, PROJW, F.G, (int)blockIdx.x);
        pg8::EpiProj E{F.UP, F.FRAG, F.YS, F.REC_G, F.REC_Y, F.VLAST, F.pool_scale, F.conv_w, F.conv_b, F.gate_b};
        for (int rep = 0; rep < (PROBE_DUP == 1 ? 2 : 1); ++rep) pg8::gemm_phase<pg8::EpiProj, pg8::StaticOrder, true, true>(F.lds + RING_OFF, g, S, E);
        if (BOTH(1)) GRID_BAR();
    }
    if (IN(2)) { for (int rep = 0; rep < (PROBE_DUP == 2 ? 2 : 1); ++rep) p2a_phase(F); if (BOTH(2)) GRID_BAR(); }
    if (IN(3)) {
        pg8::Gemm g{F.POOLED, F.PwT, PWID, PGD, PGD, 1, PGD}; pg8::StaticOrder S; S.init(MROWS, PWID, F.G, (int)blockIdx.x);
        pg8::EpiPool E{F.FRAG, F.YS};
        for (int rep = 0; rep < (PROBE_DUP == 3 ? 2 : 1); ++rep) pg8::gemm_phase<pg8::EpiPool, pg8::StaticOrder, true, true>(F.lds + RING_OFF, g, S, E);
        if (BOTH(3)) GRID_BAR();
    }
    if (IN(4)) {
        pg8::Gemm g{F.YS, F.WbrT, DM, DM, DM, 0, 0}; pg8::StaticOrder S; S.init(MROWS, DM, F.G, (int)blockIdx.x);
        pg8::EpiGate E{F.FRAG, F.MERGED};
        for (int rep = 0; rep < (PROBE_DUP == 4 ? 2 : 1); ++rep) pg8::gemm_phase<pg8::EpiGate, pg8::StaticOrder, true, true>(F.lds + RING_OFF, g, S, E);
        if (BOTH(4)) GRID_BAR();
    }
    if (IN(5)) {
        pg8::Gemm g{F.MERGED, F.WoutT, DM, DM, DM, 0, 0}; pg8::StaticOrder S; S.init(MROWS, DM, F.G, (int)blockIdx.x);
        pg8::EpiResid E{F.x, F.out, F.PART};
        for (int rep = 0; rep < (PROBE_DUP == 5 ? 2 : 1); ++rep) pg8::gemm_phase<pg8::EpiResid, pg8::StaticOrder, true, true>(F.lds + RING_OFF, g, S, E);
        if (BOTH(5)) GRID_BAR();
    }
    if (IN(6)) {
        if (DEBUG_DUMP == 0) p5_final(F);
        else { const bf16_t* src = DEBUG_DUMP == 1 ? F.YS : DEBUG_DUMP == 2 ? F.UP : DEBUG_DUMP == 3 ? F.FRAG : DEBUG_DUMP == 4 ? F.FRAG + (size_t)48 * MiB : DEBUG_DUMP == 5 ? F.POOLED : DEBUG_DUMP == 6 ? F.MERGED : (const bf16_t*)F.REC_G;
            const size_t n = (DEBUG_DUMP == 2 || DEBUG_DUMP == 5) ? (size_t)16 * MiB : (DEBUG_DUMP == 7 ? (size_t)3 * MiB : (size_t)32 * MiB);
            for (size_t i = (size_t)F.vcu * 512 + F.tid; i < (size_t)MROWS * DM; i += (size_t)F.G * 512) {
                float v = i < n ? bf_lo((unsigned)src[i]) : 0.f;
                if (DEBUG_DUMP == 8) { const size_t tile = i >> 16; v = tile < 256 ? bf_lo((unsigned)F.FRAG[((tile >> 3) * 40 + (tile & 7)) * 65536 + (i & 65535)]) : 0.f; }
                if (DEBUG_DUMP == 9) { const size_t tile = i >> 16; v = bf_lo((unsigned)F.FRAG[((tile >> 5) * 40 + 8 + (tile & 31)) * 65536 + (i & 65535)]); }
                F.out[i] = v; } }
    }
#undef IN
#undef BOTH
}

extern "C" void kernel_launch(void* const* d_in, const int* in_sizes, int n_in, void* d_out, int out_size, void* d_ws, size_t ws_size, hipStream_t stream) {
    static int grid = 0;
    if (grid == 0) {
        if (n_in != 11 || in_sizes[0] != MROWS * DM || out_size != MROWS * DM || ws_size < WS_END) {
            fprintf(stderr, "kernel_launch: unexpected shapes / workspace: n_in %d in0 %d out %d ws %zu (need %zu); nothing launched\n", n_in, n_in > 0 ? in_sizes[0] : -1, out_size, ws_size, (size_t)WS_END); grid = -1; return; }
        int dev = 0, cus = 0, per_cu = 0;
        if (hipGetDevice(&dev) != hipSuccess || hipDeviceGetAttribute(&cus, hipDeviceAttributeMultiprocessorCount, dev) != hipSuccess) { grid = -1; return; }
        if (hipFuncSetAttribute((const void*)hybrid_fwd, hipFuncAttributeMaxDynamicSharedMemorySize, LDS_BYTES) != hipSuccess) { fprintf(stderr, "kernel_launch: hipFuncSetAttribute failed\n"); grid = -1; return; }
        if (hipOccupancyMaxActiveBlocksPerMultiprocessor(&per_cu, (const void*)hybrid_fwd, NWAVES * 64, LDS_BYTES) != hipSuccess || per_cu < 1) {
            fprintf(stderr, "kernel_launch: occupancy query reports %d workgroups per CU; nothing launched\n", per_cu); (void)hipGetLastError(); grid = -1; return; }
        (void)hipGetLastError();
        grid = cus;
    }
    if (grid < 0) return;
    if (hipMemsetAsync((char*)d_ws + WS_CTL, 0, CTL_ZERO_BYTES, stream) != hipSuccess) { fprintf(stderr, "kernel_launch: hipMemsetAsync failed\n"); return; }
    Args a{};
    for (int i = 0; i < 11; ++i) a.in[i] = (const float*)d_in[i];
    a.out = (float*)d_out; a.ws = (unsigned char*)d_ws;
    for (int li = 0; li < N_LAUNCHES; ++li) {
        a.ph_lo = (N_LAUNCHES == PER_PHASE) ? li : 0; a.ph_hi = (N_LAUNCHES == PER_PHASE) ? li + 1 : PER_PHASE; a.li = li;
        hipLaunchKernelGGL(hybrid_fwd, dim3(grid), dim3(NWAVES * 64), LDS_BYTES, stream, a);
        const hipError_t le = hipPeekAtLastError();
        if (le != hipSuccess) { fprintf(stderr, "kernel_launch: launch %d failed: %s\n", li, hipGetErrorName(le)); break; }
    }
}
```
